# Optimizing an MI355X kernel written in HIP

```python
import jax, jax.numpy as jnp
from jax import lax
import numpy as np

D_MODEL = 1024
BATCH = 4
SEQ = 4096
DEPTH = 2

CHUNK = 64
N_META = 16
D_FF = 4 * D_MODEL
EPS = 1e-5

CONV_DIM = D_MODEL // 2
CONV_WIDTH = 31
POOL_DIM = D_MODEL // 2
POOL_WINDOWS = (2, 4, 8, 16)
POOL_GROUP = POOL_DIM // len(POOL_WINDOWS)
EVEN_IN = 2 * CONV_DIM + POOL_DIM
EVEN_MIX = CONV_DIM + POOL_DIM

GLA_HEADS = 4
GLA_DK = D_MODEL // 2
GLA_DV = D_MODEL
GLA_HK = GLA_DK // GLA_HEADS
GLA_HV = GLA_DV // GLA_HEADS
GLA_GATE_RANK = 16
GLA_GATE_NORM = 16.0
ODD_IN = 2 * GLA_DK + 2 * GLA_DV + GLA_GATE_RANK

N_EVEN = (DEPTH + 1) // 2
N_ODD = DEPTH // 2

kernel_name = "hybrid_conv_pool_gla_trunk"


def rms_norm(x, g):
    xf = x.astype(jnp.float32)
    y = xf * lax.rsqrt(jnp.mean(xf * xf, axis=-1, keepdims=True) + EPS)
    return (y * g.astype(jnp.float32)).astype(x.dtype)


def layer_norm(x, g, b):
    xf = x.astype(jnp.float32)
    mu = jnp.mean(xf, axis=-1, keepdims=True)
    xc = xf - mu
    y = xc * lax.rsqrt(jnp.mean(xc * xc, axis=-1, keepdims=True) + EPS)
    return (y * g.astype(jnp.float32) + b.astype(jnp.float32)).astype(x.dtype)


def causal_depthwise_conv(u, w, b):
    c = u.shape[-1]
    lhs = jnp.pad(u, ((0, 0), (CONV_WIDTH - 1, 0), (0, 0)))
    out = lax.conv_general_dilated(
        lhs, w[:, None, :].astype(u.dtype), window_strides=(1,), padding="VALID",
        dimension_numbers=("NWC", "WIO", "NWC"), feature_group_count=c)
    return out + b.astype(u.dtype)


def trailing_mean_minus_self(u, window):
    L = u.shape[1]
    uf = u.astype(jnp.float32)
    csum = jnp.cumsum(uf, axis=1)
    cpad = jnp.pad(csum, ((0, 0), (1, 0), (0, 0)))
    lower = jnp.pad(cpad[:, :L - window + 1], ((0, 0), (window - 1, 0), (0, 0)))
    count = jnp.minimum(jnp.arange(L) + 1, window).astype(jnp.float32)[None, :, None]
    return ((csum - lower) / count - uf).astype(u.dtype)


def conv_pool_mixer(h, w_in, conv_w, conv_b, ln_g, ln_b, pool_w, pool_scale, w_out):
    bsz, L, _ = h.shape
    z = h @ w_in
    a_in, p_in = z[..., :2 * CONV_DIM], z[..., 2 * CONV_DIM:]
    a = a_in[..., :CONV_DIM] * jax.nn.sigmoid(a_in[..., CONV_DIM:])
    a = causal_depthwise_conv(a, conv_w, conv_b)
    a = jax.nn.silu(layer_norm(a, ln_g, ln_b))
    groups = [trailing_mean_minus_self(p_in[..., i * POOL_GROUP:(i + 1) * POOL_GROUP], w)
              for i, w in enumerate(POOL_WINDOWS)]
    p = jnp.stack(groups, axis=2)
    p = jnp.einsum("blgc,gcd->blgd", p, pool_w).reshape(bsz, L, POOL_DIM) * pool_scale
    return jnp.concatenate([a, p], axis=-1) @ w_out


def gla_mixer(h, w_in, gate_w2, gate_b, head_g, w_out):
    bsz, L, _ = h.shape
    z = h @ w_in
    split_at = np.cumsum([GLA_DK, GLA_DK, GLA_DV, GLA_DV]).tolist()
    q, k, v, g, r = jnp.split(z, split_at, axis=-1)
    log_a = jax.nn.log_sigmoid((r @ gate_w2 + gate_b).astype(jnp.float32)) / GLA_GATE_NORM
    pad = (-L) % CHUNK
    n_chunks = (L + pad) // CHUNK

    def to_chunks(t, hd):
        t = jnp.pad(t.astype(jnp.float32), ((0, 0), (pad, 0), (0, 0)))
        return t.reshape(bsz, n_chunks, CHUNK, GLA_HEADS, hd).transpose(1, 0, 3, 2, 4)

    qc = to_chunks(q * (GLA_HK ** -0.5), GLA_HK)
    kc = to_chunks(k, GLA_HK)
    vc = to_chunks(v, GLA_HV)
    lac = to_chunks(log_a, GLA_HK)
    cum = jnp.cumsum(lac, axis=3)
    total = cum[:, :, :, -1]
    k_dec = kc * jnp.exp(total[:, :, :, None, :] - cum)

    def step(state, inp):
        q_i, k_i, v_i, tot_i = inp
        state = jnp.exp(tot_i)[..., None] * state + jnp.einsum("bhck,bhcv->bhkv", k_i, v_i)
        o_i = jnp.einsum("bhck,bhkv->bhcv", q_i, state)
        return state, o_i

    s0 = jnp.zeros((bsz, GLA_HEADS, GLA_HK, GLA_HV), jnp.float32)
    _, o = lax.scan(step, s0, (qc, k_dec, vc, total))
    o = o.transpose(1, 0, 3, 2, 4).reshape(bsz, n_chunks * CHUNK, GLA_HEADS, GLA_HV)[:, pad:]
    o = rms_norm(o, head_g).reshape(bsz, L, GLA_DV)
    o = o * jax.nn.silu(g.astype(jnp.float32))
    return o.astype(h.dtype) @ w_out


def squared_relu_mlp(u, w1, w2):
    a = jax.nn.relu(u @ w1)
    return (a * a) @ w2


def setup_inputs(seed: int = 0) -> dict:
    key = jax.random.key(seed)
    ks = jax.random.split(key, 21)
    f32 = jnp.float32
    nrm = lambda k, shape, scale: jax.random.normal(k, shape, f32) * scale
    return {
        "x": nrm(ks[0], (BATCH, SEQ, D_MODEL), 1.0),
        "meta_tokens": nrm(ks[1], (N_META, D_MODEL), 1.0),
        "mix_norm_g": 1.0 + nrm(ks[2], (DEPTH, D_MODEL), 0.02),
        "ffn_norm_g": 1.0 + nrm(ks[3], (DEPTH, D_MODEL), 0.02),
        "ffn_w1": nrm(ks[4], (DEPTH, D_MODEL, D_FF), D_MODEL ** -0.5),
        "ffn_w2": nrm(ks[5], (DEPTH, D_FF, D_MODEL), D_FF ** -0.5),
        "cp_w_in": nrm(ks[6], (N_EVEN, D_MODEL, EVEN_IN), D_MODEL ** -0.5),
        "cp_conv_w": nrm(ks[7], (N_EVEN, CONV_WIDTH, CONV_DIM), CONV_WIDTH ** -0.5),
        "cp_conv_b": nrm(ks[8], (N_EVEN, CONV_DIM), 0.02),
        "cp_ln_g": 1.0 + nrm(ks[9], (N_EVEN, CONV_DIM), 0.02),
        "cp_ln_b": nrm(ks[10], (N_EVEN, CONV_DIM), 0.02),
        "cp_pool_w": nrm(ks[11], (N_EVEN, len(POOL_WINDOWS), POOL_GROUP, POOL_GROUP), POOL_GROUP ** -0.5),
        "cp_pool_scale": 1.0 + nrm(ks[12], (N_EVEN, POOL_DIM), 0.02),
        "cp_w_out": nrm(ks[13], (N_EVEN, EVEN_MIX, D_MODEL), EVEN_MIX ** -0.5),
        "gla_w_in": nrm(ks[14], (N_ODD, D_MODEL, ODD_IN), D_MODEL ** -0.5),
        "gla_gate_w2": nrm(ks[15], (N_ODD, GLA_GATE_RANK, GLA_DK), GLA_GATE_RANK ** -0.5),
        "gla_gate_b": nrm(ks[16], (N_ODD, GLA_DK), 0.02),
        "gla_head_g": 1.0 + nrm(ks[17], (N_ODD, GLA_HV), 0.02),
        "gla_w_out": nrm(ks[18], (N_ODD, GLA_DV, D_MODEL), GLA_DV ** -0.5),
        "final_norm_g": 1.0 + nrm(ks[19], (D_MODEL,), 0.02),
    }


def reference(x, meta_tokens, mix_norm_g, ffn_norm_g, ffn_w1, ffn_w2, cp_w_in, cp_conv_w,
              cp_conv_b, cp_ln_g, cp_ln_b, cp_pool_w, cp_pool_scale, cp_w_out, gla_w_in,
              gla_gate_w2, gla_gate_b, gla_head_g, gla_w_out, final_norm_g):
    bsz = x.shape[0]
    meta = jnp.broadcast_to(meta_tokens[None].astype(x.dtype), (bsz, N_META, D_MODEL))
    h = jnp.concatenate([meta, x], axis=1)
    for i in range(DEPTH):
        j = i // 2
        u = rms_norm(h, mix_norm_g[i])
        if i % 2 == 0:
            h = h + conv_pool_mixer(u, cp_w_in[j], cp_conv_w[j], cp_conv_b[j], cp_ln_g[j],
                                    cp_ln_b[j], cp_pool_w[j], cp_pool_scale[j], cp_w_out[j])
        else:
            h = h + gla_mixer(u, gla_w_in[j], gla_gate_w2[j], gla_gate_b[j], gla_head_g[j],
                              gla_w_out[j])
        u = rms_norm(h, ffn_norm_g[i])
        h = h + squared_relu_mlp(u, ffn_w1[i], ffn_w2[i])
    return rms_norm(h[:, N_META:], final_norm_g)
```

```cpp
#include <hip/hip_runtime.h>
#include <cstdio>
#include <cstdint>

#define LAS __attribute__((address_space(3)))
typedef unsigned short bf16;
typedef short bf16x8 __attribute__((ext_vector_type(8)));
typedef short bf16x4 __attribute__((ext_vector_type(4)));
typedef float f32x4 __attribute__((ext_vector_type(4)));
typedef float f32x2 __attribute__((ext_vector_type(2)));
typedef unsigned u32x4 __attribute__((ext_vector_type(4)));
typedef unsigned u32x2 __attribute__((ext_vector_type(2)));
typedef __bf16 bf16x2_t __attribute__((ext_vector_type(2)));

constexpr int NB = 4, SEQ = 4096, D = 1024, FF = 4096, M = NB * SEQ, NMETA = 16;
constexpr int ZN0 = 1536;
constexpr int GN = 3072, GNR = 3088;
constexpr int NCH = SEQ / 64;
constexpr float EPS = 1e-5f;
constexpr int NTHREADS = 512, NWAVES = 8;

constexpr size_t MiB = 1u << 20;
constexpr size_t WS_CTL = 0, CTL_ZERO_BYTES = 1 * MiB;
constexpr size_t WS_SSQ = 1 * MiB;
constexpr size_t WS_R = 2 * MiB;
constexpr size_t WS_DTOT = 3 * MiB;
constexpr size_t WS_META = 4 * MiB;
constexpr size_t WS_W_IN0 = 5 * MiB, WS_W_OUT0 = 8 * MiB, WS_W1_0 = 10 * MiB, WS_W2_0 = 18 * MiB;
constexpr size_t WS_W_IN1 = 26 * MiB, WS_W_OUT1 = 33 * MiB, WS_W1_1 = 35 * MiB, WS_W2_1 = 43 * MiB;
constexpr size_t WS_HB = 52 * MiB;
constexpr size_t WS_S = 84 * MiB;
constexpr size_t WS_Z0 = WS_S, WS_MIX0 = WS_S + 48 * MiB;
constexpr size_t WS_A = WS_S;
constexpr size_t WS_Q = WS_S, WS_K = WS_S + 16 * MiB, WS_V = WS_S + 32 * MiB, WS_G = WS_S + 64 * MiB;
constexpr size_t WS_KDT = WS_S + 96 * MiB, WS_VT = WS_S + 112 * MiB;
constexpr size_t WS_O = WS_V;
constexpr size_t WS_END = WS_S + 144 * MiB;
static_assert(WS_END <= 256 * MiB, "workspace map");
constexpr size_t MT_HM = 0;
constexpr size_t MT_HBM = 64 * 1024;
constexpr size_t MT_ZM = 96 * 1024;
constexpr size_t MT_MIXM = 144 * 1024;
constexpr size_t MT_AM = 176 * 1024;
constexpr size_t MT_KM = 304 * 1024;
constexpr size_t MT_VM = 320 * 1024;
constexpr size_t MT_RM = 352 * 1024;
constexpr size_t MT_SSQM = 356 * 1024;
constexpr size_t MT_KDTM = 384 * 1024;
constexpr size_t MT_VTM = 448 * 1024;
static_assert(MT_VTM + 128 * 1024 <= MiB, "meta map");

constexpr int LDS_BYTES = 147456;

__device__ __forceinline__ float bf2f(bf16 b) { return __uint_as_float((unsigned)b << 16); }
__device__ __forceinline__ unsigned cvtpk(float lo, float hi) { f32x2 v = {lo, hi}; bf16x2_t b = __builtin_convertvector(v, bf16x2_t); return __builtin_bit_cast(unsigned, b); }
__device__ __forceinline__ bf16 f2bf(float f) { return (bf16)(cvtpk(f, 0.f) & 0xffffu); }
__device__ __forceinline__ float wave_sum(float v) {
#pragma unroll
    for (int o = 1; o < 64; o <<= 1) v += __shfl_xor(v, o);
    return v;
}
__device__ __forceinline__ float sigmoidf_(float x) { return __builtin_amdgcn_rcpf(1.0f + __expf(-x)); }
__device__ __forceinline__ float siluf_(float x) { return x * sigmoidf_(x); }
__device__ __forceinline__ float logsigmoidf_(float x) { return fminf(x, 0.f) - log1pf(__expf(-fabsf(x))); }
__host__ __device__ __forceinline__ int perm32(int rho) { const int n = rho >> 4, i = rho & 15; return 8 * (i >> 2) + 4 * n + (i & 3); }

struct Args { const float* in[20]; float* out; unsigned char* ws; int ph_lo, ph_hi; };

struct Ctx {
    const float* in[20]; float* out; unsigned char* ws;
    LAS unsigned char* lds;
    int tid, lane, wave, G, bid;
    __device__ __forceinline__ bf16* wsb(size_t off) const { return (bf16*)(ws + off); }
    __device__ __forceinline__ float* wsf(size_t off) const { return (float*)(ws + off); }
};

__device__ __forceinline__ void p0_transpose_item(const float* W, int K, int N, bf16* WT, const float* ksc, int qcols, float qsc, LAS float* scr, int item, int lane) {
    const int nblk = (N + 31) / 32, kb = item / nblk, nb = item % nblk, k0 = 64 * kb, n0 = 32 * nb;
    const bool nok = (n0 + (lane & 31)) < N;
#pragma unroll 8
    for (int i = 0; i < 32; ++i) { const int kk = 2 * i + (lane >> 5); float v = nok ? W[(size_t)(k0 + kk) * N + n0 + (lane & 31)] : 0.f; if (ksc) v *= ksc[k0 + kk]; scr[kk * 33 + (lane & 31)] = v; }
    asm volatile("s_waitcnt lgkmcnt(0)" ::: "memory");
    const int c = lane & 7;
#pragma unroll
    for (int j = 0; j < 4; ++j) { const int n = (lane >> 3) + 8 * j; const LAS float* s = scr + (8 * c) * 33 + n; const float sc = (n0 + n) < qcols ? qsc : 1.0f;
        u32x4 o; o.x = cvtpk(s[0 * 33] * sc, s[1 * 33] * sc); o.y = cvtpk(s[2 * 33] * sc, s[3 * 33] * sc); o.z = cvtpk(s[4 * 33] * sc, s[5 * 33] * sc); o.w = cvtpk(s[6 * 33] * sc, s[7 * 33] * sc);
        if (n0 + n < N) *(u32x4*)(WT + (size_t)(n0 + n) * K + k0 + 8 * c) = o; }
    asm volatile("s_waitcnt lgkmcnt(0)" ::: "memory");
}
__device__ __forceinline__ void p0_fold_item(const float* pw, const float* psc, const float* wo, bf16* WT, int item, int lane) {
    const int g = item >> 9, cb = (item >> 6) & 7, nb = item & 63, fr = lane & 15, fq = lane >> 4;
    const float* pa = pw + ((size_t)g * 128 + cb * 16 + fr) * 128 + fq;
    const float* sc = psc + g * 128 + fq;
    const float* pb = wo + ((size_t)(512 + g * 128 + fq)) * D + nb * 16 + fr;
    f32x4 acc = {0.f, 0.f, 0.f, 0.f};
#pragma unroll 8
    for (int db = 0; db < 32; ++db) { const float a = pa[4 * db] * sc[4 * db]; const float b = pb[(size_t)(4 * db) * D]; acc = __builtin_amdgcn_mfma_f32_16x16x4f32(a, b, acc, 0, 0, 0); }
    u32x2 o; o.x = cvtpk(acc[0], acc[1]); o.y = cvtpk(acc[2], acc[3]);
    *(u32x2*)(WT + (size_t)(nb * 16 + fr) * D + 512 + g * 128 + cb * 16 + 4 * fq) = o;
}
__device__ __forceinline__ void p0_row(const float* xrow, bf16* orow, float* ssq, int nslots, int lane) {
    const f32x4* xr = (const f32x4*)xrow + lane;
    f32x4 v[4]; float s = 0.f;
#pragma unroll
    for (int j = 0; j < 4; ++j) { v[j] = xr[64 * j]; s += (v[j].x * v[j].x + v[j].y * v[j].y) + (v[j].z * v[j].z + v[j].w * v[j].w); }
    s = wave_sum(s);
    u32x2* o8 = (u32x2*)orow + lane;
#pragma unroll
    for (int j = 0; j < 4; ++j) { u32x2 o; o.x = cvtpk(v[j].x, v[j].y); o.y = cvtpk(v[j].z, v[j].w); o8[64 * j] = o; }
    if (lane < nslots) ssq[lane] = lane == 0 ? s : 0.f;
}
__device__ __forceinline__ void phase_prologue(const Ctx& F) {
    LAS float* scr = (LAS float*)(F.lds + F.wave * 16384);
    const int gw = F.wave * F.G + F.bid, NGW = F.G * NWAVES;
    const float* mixg = F.in[2]; const float* ffng = F.in[3];
    constexpr int I_IN0 = (D / 64) * (ZN0 / 32), I_OUT0 = (512 / 64) * (D / 32), I_W1 = (D / 64) * (FF / 32), I_W2 = (FF / 64) * (D / 32);
    constexpr int I_IN1 = (D / 64) * ((GNR + 31) / 32), I_OUT1 = (D / 64) * (D / 32), I_FOLD = 4 * 8 * 64;
    constexpr int NITEMS = I_IN0 + I_OUT0 + 2 * I_W1 + 2 * I_W2 + I_IN1 + I_OUT1 + I_FOLD;
    for (int it = gw; it < NITEMS; it += NGW) {
        int r = it;
        if (r < I_IN0) { p0_transpose_item(F.in[6], D, ZN0, F.wsb(WS_W_IN0), mixg, 0, 1.f, scr, r, F.lane); continue; } r -= I_IN0;
        if (r < I_OUT0) { p0_transpose_item(F.in[13], D, D, F.wsb(WS_W_OUT0), nullptr, 0, 1.f, scr, r, F.lane); continue; } r -= I_OUT0;
        if (r < I_W1) { p0_transpose_item(F.in[4], D, FF, F.wsb(WS_W1_0), ffng, 0, 1.f, scr, r, F.lane); continue; } r -= I_W1;
        if (r < I_W1) { p0_transpose_item(F.in[4] + (size_t)D * FF, D, FF, F.wsb(WS_W1_1), ffng + D, 0, 1.f, scr, r, F.lane); continue; } r -= I_W1;
        if (r < I_W2) { p0_transpose_item(F.in[5], FF, D, F.wsb(WS_W2_0), nullptr, 0, 1.f, scr, r, F.lane); continue; } r -= I_W2;
        if (r < I_W2) { p0_transpose_item(F.in[5] + (size_t)FF * D, FF, D, F.wsb(WS_W2_1), nullptr, 0, 1.f, scr, r, F.lane); continue; } r -= I_W2;
        if (r < I_IN1) { p0_transpose_item(F.in[14], D, GNR, F.wsb(WS_W_IN1), mixg + D, 512, 0.08838834764831845f, scr, r, F.lane); continue; } r -= I_IN1;
        if (r < I_OUT1) { p0_transpose_item(F.in[18], D, D, F.wsb(WS_W_OUT1), nullptr, 0, 1.f, scr, r, F.lane); continue; } r -= I_OUT1;
        p0_fold_item(F.in[11], F.in[12], F.in[13], F.wsb(WS_W_OUT0), r, F.lane);
    }
    for (int m = gw; m < M + NMETA; m += NGW) {
        if (m < M) p0_row(F.in[0] + (size_t)m * D, F.wsb(WS_HB) + (size_t)m * D, F.wsf(WS_SSQ) + (size_t)m * 16, 16, F.lane);
        else { const int r = m - M; p0_row(F.in[1] + (size_t)r * D, F.wsb(WS_META + MT_HBM) + (size_t)r * D, F.wsf(WS_META + MT_SSQM) + (size_t)r * 64, 64, F.lane); }
    }
}

struct Unit { int pm, pn; };
typedef f32x4 Acc[2][2][4][2];

__device__ __forceinline__ void load_rs(const float* ssq, const Unit& u, int wr, int fr, int fq, float (&rs)[2][4]) {
#pragma unroll
    for (int ai = 0; ai < 2; ++ai)
#pragma unroll
        for (int m = 0; m < 4; ++m) { const int row = u.pm * 256 + ai * 128 + wr * 64 + m * 16 + fr;
            const f32x4 p = *(const f32x4*)(ssq + (size_t)row * 16 + 4 * fq); float s = (p.x + p.y) + (p.z + p.w);
            s += __shfl_xor(s, 16); s += __shfl_xor(s, 32); rs[ai][m] = rsqrtf(s * (1.0f / D) + EPS); }
}
template <int ACT, int SPLIT> struct EpiBf16S {
    const float* ssq; bf16* O; int ldc; bf16 *Q, *K, *V, *Gt;
    __device__ __forceinline__ void operator()(const Acc& acc, const Unit& u, int wr, int wc, int fr, int fq) const {
        float rs[2][4]; load_rs(ssq, u, wr, fr, fq, rs);
        bf16* base = O; int ld = ldc, colt = u.pn * 256;
        if (SPLIT) { if (u.pn < 2) { base = Q; ld = 512; } else if (u.pn < 4) { base = K; ld = 512; colt -= 512; } else if (u.pn < 8) { base = V; ld = 1024; colt -= 1024; } else { base = Gt; ld = 1024; colt -= 2048; } }
        const int row0 = u.pm * 256 + wr * 64 + fr, col0 = colt + wc * 32 + 8 * fq;
#pragma unroll
        for (int ai = 0; ai < 2; ++ai)
#pragma unroll
            for (int m = 0; m < 4; ++m) { bf16* rowp = base + (size_t)(row0 + ai * 128 + m * 16) * ld + col0; const float s = rs[ai][m];
#pragma unroll
                for (int bj = 0; bj < 2; ++bj) { f32x4 v0 = acc[ai][bj][m][0] * s, v1 = acc[ai][bj][m][1] * s;
                    if (ACT == 1) {
#pragma unroll
                        for (int e = 0; e < 4; ++e) { const float a = fmaxf(v0[e], 0.f), b = fmaxf(v1[e], 0.f); v0[e] = a * a; v1[e] = b * b; } }
                    u32x4 w; w.x = cvtpk(v0[0], v0[1]); w.y = cvtpk(v0[2], v0[3]); w.z = cvtpk(v1[0], v1[1]); w.w = cvtpk(v1[2], v1[3]);
                    *(u32x4*)(rowp + bj * 128) = w; } }
    }
};
struct EpiResid {
    const float* base; float* out; bf16* hb; float* ssq;
    __device__ __forceinline__ void operator()(const Acc& acc, const Unit& u, int wr, int wc, int fr, int fq) const {
        const int row0 = u.pm * 256 + wr * 64 + fr, col0 = u.pn * 256 + wc * 32 + 8 * fq;
#pragma unroll
        for (int ai = 0; ai < 2; ++ai)
#pragma unroll
            for (int m = 0; m < 4; ++m) { const int row = row0 + ai * 128 + m * 16; const size_t off = (size_t)row * D + col0; float ss = 0.f;
#pragma unroll
                for (int bj = 0; bj < 2; ++bj) { const f32x4 b0 = *(const f32x4*)(base + off + bj * 128), b1 = *(const f32x4*)(base + off + bj * 128 + 4);
                    const f32x4 v0 = acc[ai][bj][m][0] + b0, v1 = acc[ai][bj][m][1] + b1;
                    *(f32x4*)(out + off + bj * 128) = v0; *(f32x4*)(out + off + bj * 128 + 4) = v1;
                    u32x4 w; w.x = cvtpk(v0[0], v0[1]); w.y = cvtpk(v0[2], v0[3]); w.z = cvtpk(v1[0], v1[1]); w.w = cvtpk(v1[2], v1[3]);
                    *(u32x4*)(hb + off + bj * 128) = w;
                    ss += (v0[0] * v0[0] + v0[1] * v0[1]) + (v0[2] * v0[2] + v0[3] * v0[3]) + (v1[0] * v1[0] + v1[1] * v1[1]) + (v1[2] * v1[2] + v1[3] * v1[3]); }
                ss += __shfl_xor(ss, 16); ss += __shfl_xor(ss, 32);
                if (fq == 0) ssq[(size_t)row * 16 + u.pn * 4 + wc] = ss; }
    }
};

template <class Epi> __device__ __forceinline__ void gemm_slow(const Ctx& F, const bf16* A, const bf16* Bt, int Mr, int N, int K, const Epi& E) {
    const int wr = F.wave >> 2, wc = F.wave & 3, fr = F.lane & 15, fq = F.lane >> 4;
    const int nM = Mr / 256, nN = N / 256;
    for (int un = F.bid; un < nM * nN; un += F.G) {
        Unit u; u.pm = un / nN; u.pn = un % nN;
        Acc acc;
#pragma unroll
        for (int a = 0; a < 2; ++a)
#pragma unroll
            for (int b = 0; b < 2; ++b)
#pragma unroll
                for (int m = 0; m < 4; ++m)
#pragma unroll
                    for (int n = 0; n < 2; ++n) acc[a][b][m][n] = (f32x4){0.f, 0.f, 0.f, 0.f};
        const bf16* ap = A + (size_t)(u.pm * 256 + wr * 64 + fr) * K + 8 * fq;
        const bf16* bp0 = Bt + (size_t)(u.pn * 256 + wc * 32 + perm32(fr)) * K + 8 * fq;
        const bf16* bp1 = Bt + (size_t)(u.pn * 256 + wc * 32 + perm32(16 + fr)) * K + 8 * fq;
        for (int k0 = 0; k0 < K; k0 += 32) {
            bf16x8 a[2][4], b[2][2];
#pragma unroll
            for (int ai = 0; ai < 2; ++ai)
#pragma unroll
                for (int m = 0; m < 4; ++m) a[ai][m] = *(const bf16x8*)(ap + (size_t)(ai * 128 + m * 16) * K + k0);
#pragma unroll
            for (int bj = 0; bj < 2; ++bj) { b[bj][0] = *(const bf16x8*)(bp0 + (size_t)(bj * 128) * K + k0); b[bj][1] = *(const bf16x8*)(bp1 + (size_t)(bj * 128) * K + k0); }
#pragma unroll
            for (int ai = 0; ai < 2; ++ai)
#pragma unroll
                for (int bj = 0; bj < 2; ++bj)
#pragma unroll
                    for (int m = 0; m < 4; ++m)
#pragma unroll
                        for (int n = 0; n < 2; ++n) acc[ai][bj][m][n] = __builtin_amdgcn_mfma_f32_16x16x32_bf16(b[bj][n], a[ai][m], acc[ai][bj][m][n], 0, 0, 0);
        }
        E(acc, u, wr, wc, fr, fq);
    }
}

__device__ __forceinline__ f32x4 skinny_task(const bf16* A, int lda, const bf16* Bt, int ldb, int K, int lane) {
    const int fr = lane & 15, fq = lane >> 4;
    const bf16* ap = A + (size_t)fr * lda + 8 * fq; const bf16* bp = Bt + (size_t)fr * ldb + 8 * fq;
    f32x4 acc = {0.f, 0.f, 0.f, 0.f};
#pragma unroll 8
    for (int k = 0; k < K; k += 32) { const bf16x8 a = *(const bf16x8*)(ap + k), b = *(const bf16x8*)(bp + k); acc = __builtin_amdgcn_mfma_f32_16x16x32_bf16(b, a, acc, 0, 0, 0); }
    return acc;
}
__device__ __forceinline__ float meta_rs(const float* ssqm, int lane) {
    const int fr = lane & 15, fq = lane >> 4; const f32x4* p = (const f32x4*)(ssqm + fr * 64 + 16 * fq); float s = 0.f;
#pragma unroll
    for (int j = 0; j < 4; ++j) { const f32x4 v = p[j]; s += (v.x + v.y) + (v.z + v.w); }
    s += __shfl_xor(s, 16); s += __shfl_xor(s, 32); return rsqrtf(s * (1.0f / D) + EPS);
}
__device__ __forceinline__ int meta_task_id(const Ctx& F) { return F.wave * F.G + F.bid; }
template <int ACT> __device__ __forceinline__ void meta_scale_gemm(const Ctx& F, const bf16* Wt, int N, int K, bf16* O) {
    const bf16* hbm = F.wsb(WS_META + MT_HBM); const float* ssqm = F.wsf(WS_META + MT_SSQM);
    for (int t = meta_task_id(F); t < N / 16; t += F.G * NWAVES) {
        const float rs = meta_rs(ssqm, F.lane); f32x4 acc = skinny_task(hbm, D, Wt + (size_t)t * 16 * K, K, K, F.lane) * rs;
        if (ACT == 1) {
#pragma unroll
            for (int e = 0; e < 4; ++e) { const float a = fmaxf(acc[e], 0.f); acc[e] = a * a; } }
        u32x2 o; o.x = cvtpk(acc[0], acc[1]); o.y = cvtpk(acc[2], acc[3]);
        *(u32x2*)(O + (size_t)(F.lane & 15) * N + t * 16 + 4 * (F.lane >> 4)) = o;
    }
}
__device__ __forceinline__ void meta_resid_gemm(const Ctx& F, const bf16* A16, int K, const bf16* Wt, const float* base) {
    float* hm = F.wsf(WS_META + MT_HM); bf16* hbm = F.wsb(WS_META + MT_HBM); float* ssqm = F.wsf(WS_META + MT_SSQM);
    for (int t = meta_task_id(F); t < D / 16; t += F.G * NWAVES) {
        const int fr = F.lane & 15, fq = F.lane >> 4; const size_t off = (size_t)fr * D + t * 16 + 4 * fq;
        f32x4 acc = skinny_task(A16, K, Wt + (size_t)t * 16 * K, K, K, F.lane);
        const f32x4 v = acc + *(const f32x4*)(base + off);
        *(f32x4*)(hm + off) = v; u32x2 o; o.x = cvtpk(v[0], v[1]); o.y = cvtpk(v[2], v[3]);
        float ss = (v[0] * v[0] + v[1] * v[1]) + (v[2] * v[2] + v[3] * v[3]); ss += __shfl_xor(ss, 16); ss += __shfl_xor(ss, 32);
        *(u32x2*)(hbm + off) = o; if (fq == 0) ssqm[fr * 64 + t] = ss;
    }
}

template <int W> __device__ __forceinline__ void pool_block(const Ctx& F, float (&pw)[47], int t0s, int c, bf16* mixrow0, bool meta_unit) {
#pragma unroll
    for (int i = 0; i < 32; ++i) {
        float s = 0.f;
#pragma unroll
        for (int j = 0; j < W; ++j) s += pw[15 + i - j];
        const int tg = t0s + i + NMETA; const int cnt = tg + 1 < W ? tg + 1 : W;
        const float v = s * (1.0f / (float)cnt) - pw[15 + i];
        const bool st = meta_unit ? (i < 16) : true;
        if (st) mixrow0[(size_t)i * D + 512 + c] = f2bf(v);
    }
}
__device__ __forceinline__ void phase_convpool(const Ctx& F) {
    const int c = F.tid;
    const float* cw = F.in[7]; float w[31];
#pragma unroll
    for (int j = 0; j < 31; ++j) w[j] = cw[j * 512 + c];
    const float cb = F.in[8][c];
    const float* lng = F.in[9]; const float* lnb = F.in[10];
    const bf16* Z0 = F.wsb(WS_Z0); const bf16* ZM = F.wsb(WS_META + MT_ZM);
    bf16* MIX0 = F.wsb(WS_MIX0); bf16* MIXM = F.wsb(WS_META + MT_MIXM);
    LAS float* Y = (LAS float*)F.lds;
    const int g = c >> 7;
    for (int un = F.bid; un < 257; un += F.G) {
        const bool meta_unit = un == 256; const int b = meta_unit ? 0 : un >> 6; const int t0 = meta_unit ? -16 : (un & 63) * 64;
        float win[62], pw[47];
        for (int sb = 0; sb < (meta_unit ? 1 : 2); ++sb) {
            const int t0s = t0 + 32 * sb;
#pragma unroll
            for (int j = 0; j < 62; ++j) {
                if (sb == 1 && j < 30) { win[j] = win[j + 32]; continue; }
                const int t = t0s - 30 + j; float v = 0.f;
                if (t >= -NMETA) { const bf16* zr = t >= 0 ? Z0 + ((size_t)b * SEQ + t) * ZN0 : ZM + (size_t)(t + NMETA) * ZN0; v = bf2f(zr[c]) * sigmoidf_(bf2f(zr[512 + c])); }
                win[j] = v;
            }
#pragma unroll
            for (int j = 0; j < 47; ++j) {
                if (sb == 1 && j < 15) { pw[j] = pw[j + 32]; continue; }
                const int t = t0s - 15 + j; float v = 0.f;
                if (t >= -NMETA) { const bf16* zr = t >= 0 ? Z0 + ((size_t)b * SEQ + t) * ZN0 : ZM + (size_t)(t + NMETA) * ZN0; v = bf2f(zr[1024 + c]); }
                pw[j] = v;
            }
#pragma unroll
            for (int i = 0; i < 32; ++i) { float y = cb;
#pragma unroll
                for (int j = 0; j < 31; ++j) y = fmaf(w[j], win[i + j], y);
                Y[i * 512 + c] = y; }
            __syncthreads();
#pragma unroll
            for (int rr = 0; rr < 4; ++rr) {
                const int i = F.wave * 4 + rr; const int t = t0s + i;
                const f32x4 y0 = *(const LAS f32x4*)(Y + i * 512 + 8 * F.lane), y1 = *(const LAS f32x4*)(Y + i * 512 + 8 * F.lane + 4);
                const float mean = wave_sum((y0.x + y0.y) + (y0.z + y0.w) + (y1.x + y1.y) + (y1.z + y1.w)) * (1.0f / 512.0f);
                const f32x4 d0 = y0 - mean, d1 = y1 - mean;
                const float var = wave_sum((d0.x * d0.x + d0.y * d0.y) + (d0.z * d0.z + d0.w * d0.w) + (d1.x * d1.x + d1.y * d1.y) + (d1.z * d1.z + d1.w * d1.w)) * (1.0f / 512.0f);
                const float rstd = rsqrtf(var + EPS);
                const f32x4 g0 = *(const f32x4*)(lng + 8 * F.lane), g1 = *(const f32x4*)(lng + 8 * F.lane + 4), b0 = *(const f32x4*)(lnb + 8 * F.lane), b1 = *(const f32x4*)(lnb + 8 * F.lane + 4);
                f32x4 o0, o1;
#pragma unroll
                for (int e = 0; e < 4; ++e) { o0[e] = siluf_(d0[e] * rstd * g0[e] + b0[e]); o1[e] = siluf_(d1[e] * rstd * g1[e] + b1[e]); }
                u32x4 wv; wv.x = cvtpk(o0[0], o0[1]); wv.y = cvtpk(o0[2], o0[3]); wv.z = cvtpk(o1[0], o1[1]); wv.w = cvtpk(o1[2], o1[3]);
                const bool st = meta_unit ? (t < 0) : true;
                bf16* orow = t >= 0 ? MIX0 + ((size_t)b * SEQ + t) * D : MIXM + (size_t)(t + NMETA) * D;
                if (st) *(u32x4*)(orow + 8 * F.lane) = wv;
            }
            {
                bf16* mixrow0 = t0s >= 0 ? MIX0 + ((size_t)b * SEQ + t0s) * D : MIXM + (size_t)(t0s + NMETA) * D;
                if (g == 0) pool_block<2>(F, pw, t0s, c, mixrow0, meta_unit);
                else if (g == 1) pool_block<4>(F, pw, t0s, c, mixrow0, meta_unit);
                else if (g == 2) pool_block<8>(F, pw, t0s, c, mixrow0, meta_unit);
                else pool_block<16>(F, pw, t0s, c, mixrow0, meta_unit);
            }
            __syncthreads();
        }
    }
}

__device__ __forceinline__ void phase_prep(const Ctx& F) {
    const int kc = F.tid;
    const float* w2p = F.in[15]; float w2[16];
#pragma unroll
    for (int j = 0; j < 16; ++j) w2[j] = w2p[j * 512 + kc];
    const float gb = F.in[16][kc];
    LAS float* rl = (LAS float*)F.lds;
    for (int un = F.bid; un < 257; un += F.G) {
        const bool meta_unit = un == 256; const int nv = meta_unit ? 16 : 64;
        const size_t row0 = meta_unit ? 0 : (size_t)un * 64;
        const float* Rp = meta_unit ? F.wsf(WS_META + MT_RM) : F.wsf(WS_R) + row0 * 16;
        const bf16* Kp = meta_unit ? F.wsb(WS_META + MT_KM) : F.wsb(WS_K) + row0 * 512;
        const bf16* Vp = meta_unit ? F.wsb(WS_META + MT_VM) : F.wsb(WS_V) + row0 * 1024;
        bf16* KDT = meta_unit ? F.wsb(WS_META + MT_KDTM) : F.wsb(WS_KDT) + (size_t)un * 512 * 64;
        bf16* VT = meta_unit ? F.wsb(WS_META + MT_VTM) : F.wsb(WS_VT) + (size_t)un * 1024 * 64;
        __syncthreads();
        for (int i = F.tid; i < nv * 16; i += NTHREADS) rl[i] = Rp[i];
        __syncthreads();
        float cum[64]; float run = 0.f;
#pragma unroll
        for (int cc = 0; cc < 64; ++cc) {
            if (cc < nv) { float pre = gb;
#pragma unroll
                for (int j4 = 0; j4 < 4; ++j4) { const f32x4 r4 = *(const LAS f32x4*)(rl + cc * 16 + 4 * j4); pre = fmaf(r4.x, w2[4 * j4], pre); pre = fmaf(r4.y, w2[4 * j4 + 1], pre); pre = fmaf(r4.z, w2[4 * j4 + 2], pre); pre = fmaf(r4.w, w2[4 * j4 + 3], pre); }
                run += logsigmoidf_(pre) * (1.0f / 16.0f); }
            cum[cc] = run;
        }
        const float tot = run;
        if (!meta_unit) F.wsf(WS_DTOT)[(size_t)un * 512 + kc] = __expf(tot);
        float kd[64];
#pragma unroll
        for (int cc = 0; cc < 64; ++cc) kd[cc] = cc < nv ? bf2f(Kp[(size_t)cc * 512 + kc]) * __expf(tot - cum[cc]) : 0.f;
#pragma unroll
        for (int q8 = 0; q8 < 8; ++q8) { u32x4 o; o.x = cvtpk(kd[8 * q8], kd[8 * q8 + 1]); o.y = cvtpk(kd[8 * q8 + 2], kd[8 * q8 + 3]); o.z = cvtpk(kd[8 * q8 + 4], kd[8 * q8 + 5]); o.w = cvtpk(kd[8 * q8 + 6], kd[8 * q8 + 7]);
            *(u32x4*)(KDT + (size_t)kc * 64 + 8 * q8) = o; }
#pragma unroll
        for (int h2 = 0; h2 < 2; ++h2) { const int vv = kc + 512 * h2; unsigned short tv[64];
#pragma unroll
            for (int cc = 0; cc < 64; ++cc) tv[cc] = cc < nv ? Vp[(size_t)cc * 1024 + vv] : (unsigned short)0;
#pragma unroll
            for (int q8 = 0; q8 < 8; ++q8) { u32x4 o; o.x = tv[8 * q8] | ((unsigned)tv[8 * q8 + 1] << 16); o.y = tv[8 * q8 + 2] | ((unsigned)tv[8 * q8 + 3] << 16); o.z = tv[8 * q8 + 4] | ((unsigned)tv[8 * q8 + 5] << 16); o.w = tv[8 * q8 + 6] | ((unsigned)tv[8 * q8 + 7] << 16);
                *(u32x4*)(VT + (size_t)vv * 64 + 8 * q8) = o; } }
    }
}

struct ScanLd { bf16x8 ka0, ka1, vb0, vb1; bf16x4 q[4]; f32x4 d; };
__device__ __forceinline__ void scan_load(ScanLd& L, const bf16* kdt_row, const bf16* vt_row, const bf16* qp, const float* dp, bool real, int fq) {
    L.ka0 = *(const bf16x8*)(kdt_row + 8 * fq); L.ka1 = *(const bf16x8*)(kdt_row + 32 + 8 * fq);
    L.vb0 = *(const bf16x8*)(vt_row + 8 * fq); L.vb1 = *(const bf16x8*)(vt_row + 32 + 8 * fq);
    if (real) {
#pragma unroll
        for (int ct = 0; ct < 4; ++ct) L.q[ct] = *(const bf16x4*)(qp + (size_t)(ct * 16) * 512);
        L.d = *(const f32x4*)dp;
    } else {
#pragma unroll
        for (int ct = 0; ct < 4; ++ct) L.q[ct] = (bf16x4){0, 0, 0, 0};
        L.d = (f32x4){0.f, 0.f, 0.f, 0.f};
    }
}
__device__ __forceinline__ void phase_scan(const Ctx& F) {
    const int fr = F.lane & 15, fq = F.lane >> 4, w = F.wave;
    constexpr int PSTR = 68;
    LAS float* part = (LAS float*)F.lds;
    for (int un = F.bid; un < 256; un += F.G) {
        const int b = un >> 6, h = (un >> 4) & 3, vs = un & 15;
        const int krow = h * 128 + 16 * w + fr;
        const int vrow = h * 256 + vs * 16 + fr;
        const bf16* KDTM = F.wsb(WS_META + MT_KDTM); const bf16* VTM = F.wsb(WS_META + MT_VTM);
        const bf16* KDT = F.wsb(WS_KDT) + (size_t)b * NCH * 512 * 64; const bf16* VT = F.wsb(WS_VT) + (size_t)b * NCH * 1024 * 64;
        const bf16* Qb = F.wsb(WS_Q) + (size_t)b * SEQ * 512 + h * 128 + 16 * w + 4 * fq;
        const float* DT = F.wsf(WS_DTOT) + (size_t)b * NCH * 512 + h * 128 + 16 * w + 4 * fq;
        bf16* Ob = F.wsb(WS_O) + (size_t)b * SEQ * D + h * 256 + vs * 16;
        f32x4 S = {0.f, 0.f, 0.f, 0.f};
        ScanLd cur, nxt;
        scan_load(cur, KDTM + (size_t)krow * 64, VTM + (size_t)vrow * 64, nullptr, nullptr, false, fq);
        for (int st = 0; st <= NCH; ++st) {
            if (st < NCH) { const int n = st;
                scan_load(nxt, KDT + ((size_t)n * 512 + krow) * 64, VT + ((size_t)n * 1024 + vrow) * 64, Qb + (size_t)(n * 64 + fr) * 512, DT + (size_t)n * 512, true, fq); }
            S = S * cur.d;
            S = __builtin_amdgcn_mfma_f32_16x16x32_bf16(cur.ka0, cur.vb0, S, 0, 0, 0);
            S = __builtin_amdgcn_mfma_f32_16x16x32_bf16(cur.ka1, cur.vb1, S, 0, 0, 0);
            if (st > 0) {
                const int n = st - 1; const int pb = st & 1;
                u32x2 sb2; sb2.x = cvtpk(S[0], S[1]); sb2.y = cvtpk(S[2], S[3]); const bf16x4 sb = __builtin_bit_cast(bf16x4, sb2);
                LAS float* pw = part + ((size_t)(pb * 8 + w) * 16 + fr) * PSTR + 4 * fq;
#pragma unroll
                for (int ct = 0; ct < 4; ++ct) { const f32x4 o = __builtin_amdgcn_mfma_f32_16x16x16bf16_1k(cur.q[ct], sb, (f32x4){0.f, 0.f, 0.f, 0.f}, 0, 0, 0);
                    *(LAS f32x4*)(pw + ct * 16) = o; }
                __syncthreads();
                const int c = F.tid >> 3, v2 = (F.tid & 7) * 2; float s0 = 0.f, s1 = 0.f;
#pragma unroll
                for (int ww = 0; ww < 8; ++ww) { const LAS float* pr = part + ((size_t)(pb * 8 + ww) * 16 + v2) * PSTR + c; s0 += pr[0]; s1 += pr[PSTR]; }
                *(unsigned*)(Ob + (size_t)(n * 64 + c) * D + v2) = cvtpk(s0, s1);
            }
            cur = nxt;
        }
        __syncthreads();
    }
}

__device__ __forceinline__ void phase_gate(const Ctx& F) {
    const float* hg = F.in[17]; const f32x4 g4 = *(const f32x4*)(hg + 4 * F.lane);
    bf16* O = F.wsb(WS_O); const bf16* Gt = F.wsb(WS_G);
    const int gw = F.bid * NWAVES + F.wave, NGW = F.G * NWAVES;
    for (int it = gw; it < M * 4; it += NGW) {
        const size_t off = (size_t)it * 256 + 4 * F.lane;
        const u32x2 ov = *(const u32x2*)(O + off), gv = *(const u32x2*)(Gt + off);
        const float o0 = __uint_as_float(ov.x << 16), o1 = __uint_as_float(ov.x & 0xffff0000u), o2 = __uint_as_float(ov.y << 16), o3 = __uint_as_float(ov.y & 0xffff0000u);
        const float x0 = __uint_as_float(gv.x << 16), x1 = __uint_as_float(gv.x & 0xffff0000u), x2 = __uint_as_float(gv.y << 16), x3 = __uint_as_float(gv.y & 0xffff0000u);
        const float rs = rsqrtf(wave_sum((o0 * o0 + o1 * o1) + (o2 * o2 + o3 * o3)) * (1.0f / 256.0f) + EPS);
        u32x2 r; r.x = cvtpk(o0 * rs * g4.x * siluf_(x0), o1 * rs * g4.y * siluf_(x1)); r.y = cvtpk(o2 * rs * g4.z * siluf_(x2), o3 * rs * g4.w * siluf_(x3));
        *(u32x2*)(O + off) = r;
    }
}
__device__ __forceinline__ void phase_final(const Ctx& F) {
    const float* fg = F.in[19]; const float* ssq = F.wsf(WS_SSQ);
    const int gw = F.bid * NWAVES + F.wave, NGW = F.G * NWAVES;
    for (int m = gw; m < M; m += NGW) {
        float s = F.lane < 16 ? ssq[(size_t)m * 16 + F.lane] : 0.f; s = wave_sum(s);
        const float rs = rsqrtf(s * (1.0f / D) + EPS);
        f32x4* xr = (f32x4*)(F.out + (size_t)m * D) + F.lane;
#pragma unroll
        for (int j = 0; j < 4; ++j) { const f32x4 g = *((const f32x4*)fg + F.lane + 64 * j); f32x4 v = xr[64 * j]; v = v * rs * g; xr[64 * j] = v; }
    }
}
__device__ __forceinline__ void phase_r(const Ctx& F) {
    const bf16* Wr = F.wsb(WS_W_IN1) + (size_t)GN * D; const bf16* hb = F.wsb(WS_HB); const float* ssq = F.wsf(WS_SSQ); float* R = F.wsf(WS_R);
    const int gw = F.bid * NWAVES + F.wave, NGW = F.G * NWAVES;
    for (int t = gw; t < M / 16; t += NGW) {
        const int fr = F.lane & 15, fq = F.lane >> 4; const int row = t * 16 + fr;
        const f32x4 p = *(const f32x4*)(ssq + (size_t)row * 16 + 4 * fq); float s = (p.x + p.y) + (p.z + p.w); s += __shfl_xor(s, 16); s += __shfl_xor(s, 32);
        const float rs = rsqrtf(s * (1.0f / D) + EPS);
        const f32x4 acc = skinny_task(hb + (size_t)t * 16 * D, D, Wr, D, D, F.lane) * rs;
        *(f32x4*)(R + (size_t)row * 16 + 4 * fq) = acc;
    }
}
__device__ __forceinline__ void meta_in1(const Ctx& F) {
    const bf16* hbm = F.wsb(WS_META + MT_HBM); const float* ssqm = F.wsf(WS_META + MT_SSQM); const bf16* Wt = F.wsb(WS_W_IN1);
    for (int t = meta_task_id(F); t < (GNR - 512) / 16; t += F.G * NWAVES) {
        const int n0 = 512 + t * 16; if (n0 >= 2048 && n0 < GN) continue;
        const int fr = F.lane & 15, fq = F.lane >> 4;
        const float rs = meta_rs(ssqm, F.lane); const f32x4 acc = skinny_task(hbm, D, Wt + (size_t)n0 * D, D, D, F.lane) * rs;
        u32x2 o; o.x = cvtpk(acc[0], acc[1]); o.y = cvtpk(acc[2], acc[3]);
        if (n0 < 1024) *(u32x2*)(F.wsb(WS_META + MT_KM) + (size_t)fr * 512 + (n0 - 512) + 4 * fq) = o;
        else if (n0 < 2048) *(u32x2*)(F.wsb(WS_META + MT_VM) + (size_t)fr * 1024 + (n0 - 1024) + 4 * fq) = o;
        else *(f32x4*)(F.wsf(WS_META + MT_RM) + fr * 16 + 4 * fq) = acc;
    }
}


constexpr int CW_BAR = 4096;
constexpr int LDSCTL_OFF = 131072, MISC_OFF = LDSCTL_OFF + 320;
#define XB_TMO      128
#define XB_XCNT(j)  (256  + 64 * (j))
#define XB_XSUB(j)  (1280 + 64 * (j))
#define XB_XGEN(j)  (2304 + 64 * (j))
#define XB_TOP      3328
#define XB_TOPGEN   3392
#define XCD_BAR_WORDS 3456
#define XB_SPIN_CAP (1u << 18)
__device__ __forceinline__ unsigned xb_ld(unsigned* p)              { return __hip_atomic_load(p, __ATOMIC_RELAXED, __HIP_MEMORY_SCOPE_AGENT); }
__device__ __forceinline__ unsigned xb_add(unsigned* p, unsigned v) { return __hip_atomic_fetch_add(p, v, __ATOMIC_RELAXED, __HIP_MEMORY_SCOPE_AGENT); }
__device__ __forceinline__ unsigned xb_xcc_id() { return (unsigned)__builtin_amdgcn_s_getreg((3 << 11) | 20) & 0xFu; }
#define XB_SPIN(cond, bar) do { unsigned _sp = 0; while (cond) { __builtin_amdgcn_s_sleep(1); \
    if ((++_sp & 255u) == 0u) { if (xb_ld(&(bar)[XB_TMO])) break; if (_sp > XB_SPIN_CAP) { atomicAdd(&(bar)[XB_TMO], 1u); break; } } } } while (0)
struct XcdBarrier { unsigned* bar; unsigned x; volatile LAS unsigned* st; };
__device__ __forceinline__ XcdBarrier xcd_barrier_post(unsigned* bar, volatile LAS unsigned* st) {
    XcdBarrier b; b.bar = bar; b.x = xb_xcc_id(); b.st = st;
    if (threadIdx.x == 0) (void)xb_add(&bar[XB_XCNT(b.x)], 1u);
    return b;
}
__device__ __forceinline__ void xcd_barrier_complete(unsigned* bar, unsigned x, unsigned& nloc, unsigned& nx) {
    const unsigned G = gridDim.x * gridDim.y * gridDim.z;
    unsigned sum, cnt, mine, sp = 0u;
    for (;;) {
        sum = 0u; cnt = 0u; mine = 0u;
#pragma unroll
        for (unsigned j = 0; j < 16; ++j) { const unsigned c = xb_ld(&bar[XB_XCNT(j)]); sum += c; cnt += (c > 0u) ? 1u : 0u; mine = (j == x) ? c : mine; }
        if (sum == G) break;
        __builtin_amdgcn_s_sleep(1);
        if ((++sp & 255u) == 0u) { if (xb_ld(&bar[XB_TMO])) break; if (sp > XB_SPIN_CAP) { atomicAdd(&bar[XB_TMO], 1u); break; } }
    }
    nloc = mine > 0u ? mine : 1u; nx = cnt > 0u ? cnt : 1u;
}
__device__ __forceinline__ void xcd_barrier(const XcdBarrier& b) {
    asm volatile("s_waitcnt vmcnt(0)" ::: "memory");
    __syncthreads();
    if (threadIdx.x == 0) {
        unsigned* bar = b.bar;
        __builtin_amdgcn_s_waitcnt(0);
        unsigned nloc = b.st[0], nx = b.st[1];
        if (nloc == 0u) { xcd_barrier_complete(bar, b.x, nloc, nx); b.st[0] = nloc; b.st[1] = nx; }
        const unsigned old = xb_add(&bar[XB_XSUB(b.x)], 1u);
        const unsigned gen = old / nloc;
        if (old + 1u == (gen + 1u) * nloc) {
            __builtin_amdgcn_fence(__ATOMIC_RELEASE, "agent");
            asm volatile("s_waitcnt vmcnt(0)" ::: "memory");
            const unsigned og = xb_add(&bar[XB_TOP], 1u);
            const unsigned tg = og / nx;
            if (og + 1u == (tg + 1u) * nx) xb_add(&bar[XB_TOPGEN], 1u);
            else XB_SPIN(xb_ld(&bar[XB_TOPGEN]) == tg, bar);
            __builtin_amdgcn_fence(__ATOMIC_ACQUIRE, "agent");
            xb_add(&bar[XB_XGEN(b.x)], 1u);
            asm volatile("s_waitcnt vmcnt(0)" ::: "memory");
        } else {
            XB_SPIN(xb_ld(&bar[XB_XGEN(b.x)]) == gen, bar);
            __builtin_amdgcn_fence(__ATOMIC_ACQUIRE, "agent");
            asm volatile("s_waitcnt vmcnt(0)" ::: "memory");
        }
    }
    __syncthreads();
}

constexpr int N_PHASES = 14;
__global__ void __launch_bounds__(NTHREADS, 2) fwd_kernel(Args args) {
    extern __shared__ __attribute__((aligned(16))) unsigned char lds_raw[];
    Ctx F;
#pragma unroll
    for (int i = 0; i < 20; ++i) F.in[i] = args.in[i];
    F.out = args.out; F.ws = args.ws; F.lds = (LAS unsigned char*)lds_raw;
    F.tid = threadIdx.x; F.lane = F.tid & 63; F.wave = __builtin_amdgcn_readfirstlane(F.tid >> 6); F.G = gridDim.x; F.bid = blockIdx.x;
    const int lo = args.ph_lo, hi = args.ph_hi;
    for (int u = F.tid; u < (LDS_BYTES - LDSCTL_OFF) / 4; u += NTHREADS) ((LAS unsigned*)(F.lds + LDSCTL_OFF))[u] = 0u;
    __syncthreads();
    XcdBarrier bar = xcd_barrier_post((unsigned*)(F.ws + WS_CTL) + CW_BAR, (volatile LAS unsigned*)(F.lds + MISC_OFF) + 8);
#define IN(k) (lo <= (k) && (k) < hi)
#define SEAM(k) do { if (IN(k) && IN((k) + 1)) xcd_barrier(bar); } while (0)
    if (IN(0)) phase_prologue(F);
    SEAM(0);
    if (IN(1)) {
        meta_scale_gemm<0>(F, F.wsb(WS_W_IN0), ZN0, D, F.wsb(WS_META + MT_ZM));
        EpiBf16S<0, 0> E{F.wsf(WS_SSQ), F.wsb(WS_Z0), ZN0, nullptr, nullptr, nullptr, nullptr};
        gemm_slow(F, F.wsb(WS_HB), F.wsb(WS_W_IN0), M, ZN0, D, E);
    }
    SEAM(1);
    if (IN(2)) phase_convpool(F);
    SEAM(2);
    if (IN(3)) {
        meta_resid_gemm(F, F.wsb(WS_META + MT_MIXM), D, F.wsb(WS_W_OUT0), F.in[1]);
        EpiResid E{F.in[0], F.out, F.wsb(WS_HB), F.wsf(WS_SSQ)};
        gemm_slow(F, F.wsb(WS_MIX0), F.wsb(WS_W_OUT0), M, D, D, E);
    }
    SEAM(3);
    if (IN(4)) {
        meta_scale_gemm<1>(F, F.wsb(WS_W1_0), FF, D, F.wsb(WS_META + MT_AM));
        EpiBf16S<1, 0> E{F.wsf(WS_SSQ), F.wsb(WS_A), FF, nullptr, nullptr, nullptr, nullptr};
        gemm_slow(F, F.wsb(WS_HB), F.wsb(WS_W1_0), M, FF, D, E);
    }
    SEAM(4);
    if (IN(5)) {
        meta_resid_gemm(F, F.wsb(WS_META + MT_AM), FF, F.wsb(WS_W2_0), F.wsf(WS_META + MT_HM));
        EpiResid E{F.out, F.out, F.wsb(WS_HB), F.wsf(WS_SSQ)};
        gemm_slow(F, F.wsb(WS_A), F.wsb(WS_W2_0), M, D, FF, E);
    }
    SEAM(5);
    if (IN(6)) {
        meta_in1(F);
        phase_r(F);
        EpiBf16S<0, 1> E{F.wsf(WS_SSQ), nullptr, 0, F.wsb(WS_Q), F.wsb(WS_K), F.wsb(WS_V), F.wsb(WS_G)};
        gemm_slow(F, F.wsb(WS_HB), F.wsb(WS_W_IN1), M, GN, D, E);
    }
    SEAM(6);
    if (IN(7)) phase_prep(F);
    SEAM(7);
    if (IN(8)) phase_scan(F);
    SEAM(8);
    if (IN(9)) phase_gate(F);
    SEAM(9);
    if (IN(10)) {
        EpiResid E{F.out, F.out, F.wsb(WS_HB), F.wsf(WS_SSQ)};
        gemm_slow(F, F.wsb(WS_O), F.wsb(WS_W_OUT1), M, D, D, E);
    }
    SEAM(10);
    if (IN(11)) {
        EpiBf16S<1, 0> E{F.wsf(WS_SSQ), F.wsb(WS_A), FF, nullptr, nullptr, nullptr, nullptr};
        gemm_slow(F, F.wsb(WS_HB), F.wsb(WS_W1_1), M, FF, D, E);
    }
    SEAM(11);
    if (IN(12)) {
        EpiResid E{F.out, F.out, F.wsb(WS_HB), F.wsf(WS_SSQ)};
        gemm_slow(F, F.wsb(WS_A), F.wsb(WS_W2_1), M, D, FF, E);
    }
    SEAM(12);
    if (IN(13)) phase_final(F);
#undef IN
#undef SEAM
}

extern "C" void kernel_launch(void* const* d_in, const int* in_sizes, int n_in, void* d_out, int out_size, void* d_ws, size_t ws_size, hipStream_t stream) {
    static int grid = 0;
    if (grid == 0) {
        if (n_in != 20 || in_sizes[0] != M * D || out_size != M * D || ws_size < WS_END) { fprintf(stderr, "kernel_launch: unexpected shapes (n_in %d, in0 %d, out %d, ws %zu)\n", n_in, n_in > 0 ? in_sizes[0] : -1, out_size, ws_size); grid = -1; return; }
        int dev = 0, cus = 0, per_cu = 0;
        (void)hipGetDevice(&dev); (void)hipDeviceGetAttribute(&cus, hipDeviceAttributeMultiprocessorCount, dev);
        (void)hipFuncSetAttribute((const void*)fwd_kernel, hipFuncAttributeMaxDynamicSharedMemorySize, LDS_BYTES);
        (void)hipOccupancyMaxActiveBlocksPerMultiprocessor(&per_cu, (const void*)fwd_kernel, NTHREADS, LDS_BYTES);
        (void)hipGetLastError();
        if (per_cu < 1) per_cu = 1;
        grid = cus * (per_cu < 1 ? per_cu : 1);
    }
    if (grid < 0) return;
    (void)hipMemsetAsync((char*)d_ws + WS_CTL, 0, CTL_ZERO_BYTES, stream);
    Args a{};
    for (int i = 0; i < 20; ++i) a.in[i] = (const float*)d_in[i];
    a.out = (float*)d_out; a.ws = (unsigned char*)d_ws;
#if defined(MK_PER_PHASE)
    for (int p = 0; p < N_PHASES; ++p) { a.ph_lo = p; a.ph_hi = p + 1; hipLaunchKernelGGL(fwd_kernel, dim3(grid), dim3(NTHREADS), LDS_BYTES, stream, a); }
#else
    a.ph_lo = 0; a.ph_hi = N_PHASES; hipLaunchKernelGGL(fwd_kernel, dim3(grid), dim3(NTHREADS), LDS_BYTES, stream, a);
#endif
}
```

```cpp
#include <hip/hip_runtime.h>
#include <cstdio>
#include <cstdint>

#define LAS __attribute__((address_space(3)))
typedef unsigned short bf16;
typedef short bf16x8 __attribute__((ext_vector_type(8)));
typedef short bf16x4 __attribute__((ext_vector_type(4)));
typedef float f32x4 __attribute__((ext_vector_type(4)));
typedef float f32x2 __attribute__((ext_vector_type(2)));
typedef unsigned u32x4 __attribute__((ext_vector_type(4)));
typedef unsigned u32x2 __attribute__((ext_vector_type(2)));
typedef __bf16 bf16x2_t __attribute__((ext_vector_type(2)));

constexpr int NB = 4, SEQ = 4096, D = 1024, FF = 4096, M = NB * SEQ, NMETA = 16;
constexpr int ZN0 = 1536;
constexpr int GN = 3072, GNR = 3088;
constexpr int NCH = SEQ / 64;
constexpr float EPS = 1e-5f;
constexpr int NTHREADS = 512, NWAVES = 8;

constexpr size_t MiB = 1u << 20;
constexpr size_t WS_CTL = 0, CTL_ZERO_BYTES = 1 * MiB;
constexpr size_t WS_SSQ = 1 * MiB;
constexpr size_t WS_R = 2 * MiB;
constexpr size_t WS_DTOT = 3 * MiB;
constexpr size_t WS_META = 4 * MiB;
constexpr size_t WS_W_IN0 = 5 * MiB, WS_W_OUT0 = 8 * MiB, WS_W1_0 = 10 * MiB, WS_W2_0 = 18 * MiB;
constexpr size_t WS_W_IN1 = 26 * MiB, WS_W_OUT1 = 33 * MiB, WS_W1_1 = 35 * MiB, WS_W2_1 = 43 * MiB;
constexpr size_t WS_HB = 52 * MiB;
constexpr size_t WS_S = 84 * MiB;
constexpr size_t WS_Z0 = WS_S, WS_MIX0 = WS_S + 48 * MiB;
constexpr size_t WS_A = WS_S;
constexpr size_t WS_Q = WS_S, WS_K = WS_S + 16 * MiB, WS_V = WS_S + 32 * MiB, WS_G = WS_S + 64 * MiB;
constexpr size_t WS_KDT = WS_S + 96 * MiB, WS_VT = WS_S + 112 * MiB;
constexpr size_t WS_O = WS_V;
constexpr size_t WS_END = WS_S + 144 * MiB;
static_assert(WS_END <= 256 * MiB, "workspace map");
constexpr size_t MT_HM = 0;
constexpr size_t MT_HBM = 64 * 1024;
constexpr size_t MT_ZM = 96 * 1024;
constexpr size_t MT_MIXM = 144 * 1024;
constexpr size_t MT_AM = 176 * 1024;
constexpr size_t MT_KM = 304 * 1024;
constexpr size_t MT_VM = 320 * 1024;
constexpr size_t MT_RM = 352 * 1024;
constexpr size_t MT_SSQM = 356 * 1024;
constexpr size_t MT_KDTM = 384 * 1024;
constexpr size_t MT_VTM = 448 * 1024;
static_assert(MT_VTM + 128 * 1024 <= MiB, "meta map");

constexpr int LDS_BYTES = 147456;

__device__ __forceinline__ float bf2f(bf16 b) { return __uint_as_float((unsigned)b << 16); }
__device__ __forceinline__ unsigned cvtpk(float lo, float hi) { f32x2 v = {lo, hi}; bf16x2_t b = __builtin_convertvector(v, bf16x2_t); return __builtin_bit_cast(unsigned, b); }
__device__ __forceinline__ bf16 f2bf(float f) { return (bf16)(cvtpk(f, 0.f) & 0xffffu); }
__device__ __forceinline__ float wave_sum(float v) {
#pragma unroll
    for (int o = 1; o < 64; o <<= 1) v += __shfl_xor(v, o);
    return v;
}
__device__ __forceinline__ float sigmoidf_(float x) { return __builtin_amdgcn_rcpf(1.0f + __expf(-x)); }
__device__ __forceinline__ float siluf_(float x) { return x * sigmoidf_(x); }
__device__ __forceinline__ float logsigmoidf_(float x) { return fminf(x, 0.f) - log1pf(__expf(-fabsf(x))); }
__host__ __device__ __forceinline__ int perm32(int rho) { const int n = rho >> 4, i = rho & 15; return 8 * (i >> 2) + 4 * n + (i & 3); }

struct Args { const float* in[20]; float* out; unsigned char* ws; int ph_lo, ph_hi; };

struct Ctx {
    const float* in[20]; float* out; unsigned char* ws;
    LAS unsigned char* lds;
    int tid, lane, wave, G, bid;
    __device__ __forceinline__ bf16* wsb(size_t off) const { return (bf16*)(ws + off); }
    __device__ __forceinline__ float* wsf(size_t off) const { return (float*)(ws + off); }
};

__device__ __forceinline__ void p0_transpose_item(const float* W, int K, int N, bf16* WT, const float* ksc, int qcols, float qsc, LAS float* scr, int item, int lane) {
    const int nblk = (N + 31) / 32, kb = item / nblk, nb = item % nblk, k0 = 64 * kb, n0 = 32 * nb;
    const bool nok = (n0 + (lane & 31)) < N;
#pragma unroll 8
    for (int i = 0; i < 32; ++i) { const int kk = 2 * i + (lane >> 5); float v = nok ? W[(size_t)(k0 + kk) * N + n0 + (lane & 31)] : 0.f; if (ksc) v *= ksc[k0 + kk]; scr[kk * 33 + (lane & 31)] = v; }
    asm volatile("s_waitcnt lgkmcnt(0)" ::: "memory");
    const int c = lane & 7;
#pragma unroll
    for (int j = 0; j < 4; ++j) { const int n = (lane >> 3) + 8 * j; const LAS float* s = scr + (8 * c) * 33 + n; const float sc = (n0 + n) < qcols ? qsc : 1.0f;
        u32x4 o; o.x = cvtpk(s[0 * 33] * sc, s[1 * 33] * sc); o.y = cvtpk(s[2 * 33] * sc, s[3 * 33] * sc); o.z = cvtpk(s[4 * 33] * sc, s[5 * 33] * sc); o.w = cvtpk(s[6 * 33] * sc, s[7 * 33] * sc);
        if (n0 + n < N) *(u32x4*)(WT + (size_t)(n0 + n) * K + k0 + 8 * c) = o; }
    asm volatile("s_waitcnt lgkmcnt(0)" ::: "memory");
}
__device__ __forceinline__ void p0_fold_item(const float* pw, const float* psc, const float* wo, bf16* WT, int item, int lane) {
    const int g = item >> 9, cb = (item >> 6) & 7, nb = item & 63, fr = lane & 15, fq = lane >> 4;
    const float* pa = pw + ((size_t)g * 128 + cb * 16 + fr) * 128 + fq;
    const float* sc = psc + g * 128 + fq;
    const float* pb = wo + ((size_t)(512 + g * 128 + fq)) * D + nb * 16 + fr;
    f32x4 acc = {0.f, 0.f, 0.f, 0.f};
#pragma unroll 8
    for (int db = 0; db < 32; ++db) { const float a = pa[4 * db] * sc[4 * db]; const float b = pb[(size_t)(4 * db) * D]; acc = __builtin_amdgcn_mfma_f32_16x16x4f32(a, b, acc, 0, 0, 0); }
    u32x2 o; o.x = cvtpk(acc[0], acc[1]); o.y = cvtpk(acc[2], acc[3]);
    *(u32x2*)(WT + (size_t)(nb * 16 + fr) * D + 512 + g * 128 + cb * 16 + 4 * fq) = o;
}
__device__ __forceinline__ void p0_row(const float* xrow, bf16* orow, float* ssq, int nslots, int lane) {
    const f32x4* xr = (const f32x4*)xrow + lane;
    f32x4 v[4]; float s = 0.f;
#pragma unroll
    for (int j = 0; j < 4; ++j) { v[j] = xr[64 * j]; s += (v[j].x * v[j].x + v[j].y * v[j].y) + (v[j].z * v[j].z + v[j].w * v[j].w); }
    s = wave_sum(s);
    u32x2* o8 = (u32x2*)orow + lane;
#pragma unroll
    for (int j = 0; j < 4; ++j) { u32x2 o; o.x = cvtpk(v[j].x, v[j].y); o.y = cvtpk(v[j].z, v[j].w); o8[64 * j] = o; }
    if (lane < nslots) ssq[lane] = lane == 0 ? s : 0.f;
}
__device__ __forceinline__ void phase_prologue(const Ctx& F) {
    LAS float* scr = (LAS float*)(F.lds + F.wave * 16384);
    const int gw = F.wave * F.G + F.bid, NGW = F.G * NWAVES;
    const float* mixg = F.in[2]; const float* ffng = F.in[3];
    constexpr int I_IN0 = (D / 64) * (ZN0 / 32), I_OUT0 = (512 / 64) * (D / 32), I_W1 = (D / 64) * (FF / 32), I_W2 = (FF / 64) * (D / 32);
    constexpr int I_IN1 = (D / 64) * ((GNR + 31) / 32), I_OUT1 = (D / 64) * (D / 32), I_FOLD = 4 * 8 * 64;
    constexpr int NITEMS = I_IN0 + I_OUT0 + 2 * I_W1 + 2 * I_W2 + I_IN1 + I_OUT1 + I_FOLD;
    for (int it = gw; it < NITEMS; it += NGW) {
        int r = it;
        if (r < I_IN0) { p0_transpose_item(F.in[6], D, ZN0, F.wsb(WS_W_IN0), mixg, 0, 1.f, scr, r, F.lane); continue; } r -= I_IN0;
        if (r < I_OUT0) { p0_transpose_item(F.in[13], D, D, F.wsb(WS_W_OUT0), nullptr, 0, 1.f, scr, r, F.lane); continue; } r -= I_OUT0;
        if (r < I_W1) { p0_transpose_item(F.in[4], D, FF, F.wsb(WS_W1_0), ffng, 0, 1.f, scr, r, F.lane); continue; } r -= I_W1;
        if (r < I_W1) { p0_transpose_item(F.in[4] + (size_t)D * FF, D, FF, F.wsb(WS_W1_1), ffng + D, 0, 1.f, scr, r, F.lane); continue; } r -= I_W1;
        if (r < I_W2) { p0_transpose_item(F.in[5], FF, D, F.wsb(WS_W2_0), nullptr, 0, 1.f, scr, r, F.lane); continue; } r -= I_W2;
        if (r < I_W2) { p0_transpose_item(F.in[5] + (size_t)FF * D, FF, D, F.wsb(WS_W2_1), nullptr, 0, 1.f, scr, r, F.lane); continue; } r -= I_W2;
        if (r < I_IN1) { p0_transpose_item(F.in[14], D, GNR, F.wsb(WS_W_IN1), mixg + D, 512, 0.08838834764831845f, scr, r, F.lane); continue; } r -= I_IN1;
        if (r < I_OUT1) { p0_transpose_item(F.in[18], D, D, F.wsb(WS_W_OUT1), nullptr, 0, 1.f, scr, r, F.lane); continue; } r -= I_OUT1;
        p0_fold_item(F.in[11], F.in[12], F.in[13], F.wsb(WS_W_OUT0), r, F.lane);
    }
    for (int m = gw; m < M + NMETA; m += NGW) {
        if (m < M) p0_row(F.in[0] + (size_t)m * D, F.wsb(WS_HB) + (size_t)m * D, F.wsf(WS_SSQ) + (size_t)m * 16, 16, F.lane);
        else { const int r = m - M; p0_row(F.in[1] + (size_t)r * D, F.wsb(WS_META + MT_HBM) + (size_t)r * D, F.wsf(WS_META + MT_SSQM) + (size_t)r * 64, 64, F.lane); }
    }
}

namespace pg8 {
#define PG8_LAS __attribute__((address_space(3)))
typedef unsigned short bf16_t;
typedef short bf16x8 __attribute__((ext_vector_type(8)));
typedef float f32x4 __attribute__((ext_vector_type(4)));
typedef unsigned u32x4 __attribute__((ext_vector_type(4)));
constexpr int BM = 256, BK = 64, HALF = 128, HTB = HALF * BK * 2  , STAGE_BYTES = 8 * HTB, NXCD = 8, WGM = 8;

__host__ __device__ __forceinline__ int lds_byte(int r, int c) { const int st = (r >> 4) * 2 + (c >> 5), rr = r & 15, cc = c & 31, ob = rr * 64 + cc * 2; return st * 1024 + (ob ^ (((ob >> 9) & 1) << 5)); }
__host__ __device__ __forceinline__ void stage_rc(int b, int& R, int& C) { const int st = b / 1024, sb = b % 1024, swz = sb ^ (((sb >> 9) & 1) << 5); R = (st >> 1) * 16 + swz / 64; C = (st & 1) * 32 + (swz % 64) / 2; }
__host__ __device__ __forceinline__ int perm32(int rho) { const int n = rho >> 4, i = rho & 15; return 8 * (i >> 2) + 4 * n + (i & 3); }

struct Unit { int pm, pn; };
struct Gemm { const bf16_t* A; const bf16_t* Bt; int M, N, K; };

struct StaticOrder {
    int nM, nN, nwg, G, c;
    __host__ __device__ void init(int M, int N, int G_, int c_) { nM = M / BM; nN = N / BM; nwg = nM * nN; G = G_; c = c_; }
    __host__ __device__ bool next(int i, Unit& u) const {
        const long L = (long)i * G + c; if (L >= nwg) return false;
        int wgid = (int)L; { const int q = nwg / NXCD, r = nwg % NXCD, xcd = wgid % NXCD, off = wgid / NXCD; wgid = (xcd < r ? xcd * (q + 1) : r * (q + 1) + (xcd - r) * q) + off; }
        const int nig = WGM * nN, gid = wgid / nig, fm = gid * WGM, gsz = (nM - fm) < WGM ? (nM - fm) : WGM;
        u.pm = fm + ((wgid % nig) % gsz); u.pn = (wgid % nig) / gsz; return true;
    }
    __device__ __forceinline__ void a_ready(const Unit&) const {}
    __device__ __forceinline__ void done(const Unit&) const {}
};

template <class Epi, class Sched, bool ALIGN_EPI = false, bool SP2 = false>
__device__ __forceinline__ void gemm_phase(PG8_LAS unsigned char* lds, const Gemm g, const Sched& S, const Epi& E) {
    const int tid = threadIdx.x, wid = __builtin_amdgcn_readfirstlane(tid >> 6), lane = tid & 63, wr = wid >> 2, wc = wid & 3, fr = lane & 15, fq = lane >> 4;
    const int K = g.K, nt = K / BK;
    unsigned voffA[2], voffB[2];
#pragma unroll
    for (int i = 0; i < 2; ++i) { int R, C; stage_rc(tid * 16 + i * 8192, R, C); const int Rb = Epi::PERM ? ((R & ~31) + perm32(R & 31)) : R;
        voffA[i] = (unsigned)(R * K + C) * 2u; voffB[i] = (unsigned)(Rb * K + C) * 2u; }
    const size_t kstep = (size_t)(BK * 2);
    const size_t hstep = (size_t)HALF * K * 2;
    const size_t tstep = 2 * hstep;
    const unsigned ldsw = (unsigned)wid * 1024u;
    const int aoff = lds_byte(wr * 64 + fr, fq * 8), boff = lds_byte(wc * 32 + fr, fq * 8);
#define PG8_SA(b, h) (((b) * 2 + (h)) * HTB)
#define PG8_SB(b, h) ((4 + (b) * 2 + (h)) * HTB)
#define PG8_STAGE(bufoff, gbase, voff) do { _Pragma("unroll") for (int _i = 0; _i < 2; ++_i) \
        __builtin_amdgcn_global_load_lds((const unsigned*)((const char*)(gbase) + (voff)[_i]), (PG8_LAS unsigned*)(lds + (bufoff) + ldsw + _i * 8192), 16, 0, 0); } while (0)
#define PG8_LDA(dst, b, h) do { _Pragma("unroll") for (int m = 0; m < 4; ++m) _Pragma("unroll") for (int k = 0; k < 2; ++k) dst[m][k] = *(const PG8_LAS bf16x8*)(lds + PG8_SA(b, h) + aoff + m * 2048 + k * 1024); } while (0)
#define PG8_LDB(dst, b, h) do { _Pragma("unroll") for (int n = 0; n < 2; ++n) _Pragma("unroll") for (int k = 0; k < 2; ++k) dst[n][k] = *(const PG8_LAS bf16x8*)(lds + PG8_SB(b, h) + boff + n * 2048 + k * 1024); } while (0)
#define PG8_MMA(ai, bj, At, Bt) do { __builtin_amdgcn_s_setprio(1); _Pragma("unroll") for (int m = 0; m < 4; ++m) _Pragma("unroll") for (int n = 0; n < 2; ++n) _Pragma("unroll") for (int k = 0; k < 2; ++k) \
        acc[ai][bj][m][n] = __builtin_amdgcn_mfma_f32_16x16x32_bf16(Bt[n][k], At[m][k], acc[ai][bj][m][n], 0, 0, 0); __builtin_amdgcn_s_setprio(0); } while (0)
#define PG8_WAIT_V(n) asm volatile("s_waitcnt vmcnt(" #n ")" ::: "memory")
#define PG8_WAIT_L(n) asm volatile("s_waitcnt lgkmcnt(" #n ")" ::: "memory")
#define PG8_BAR __builtin_amdgcn_s_barrier()
#define PG8_SCHED __builtin_amdgcn_sched_barrier(0)
    Unit cur, nxt; int ui = 0;
    if (!S.next(0, cur)) return;
    f32x4 acc[2][2][4][2];
#pragma unroll
    for (int a = 0; a < 2; ++a)
#pragma unroll
        for (int b = 0; b < 2; ++b)
#pragma unroll
            for (int m = 0; m < 4; ++m)
#pragma unroll
                for (int n = 0; n < 2; ++n) acc[a][b][m][n] = (f32x4){0.f, 0.f, 0.f, 0.f};
    bf16x8 At[4][2], B0[2][2], B1[2][2];
    const char* cA = (const char*)g.A + (size_t)cur.pm * tstep; const char* cB = (const char*)g.Bt + (size_t)cur.pn * tstep;
    S.a_ready(cur);
    if constexpr (SP2) {
        PG8_STAGE(PG8_SB(0, 0), cB, voffB); PG8_STAGE(PG8_SB(0, 1), cB + hstep, voffB); PG8_STAGE(PG8_SA(0, 0), cA, voffA); PG8_STAGE(PG8_SA(0, 1), cA + hstep, voffA);
        if (wr == 1) PG8_BAR;
        PG8_WAIT_V(2); PG8_BAR;
        PG8_STAGE(PG8_SB(1, 0), cB + kstep, voffB); PG8_STAGE(PG8_SA(1, 0), cA + kstep, voffA); PG8_STAGE(PG8_SB(1, 1), cB + hstep + kstep, voffB);
        PG8_WAIT_V(6); PG8_BAR;
    } else {
        PG8_STAGE(PG8_SB(0, 0), cB, voffB); PG8_STAGE(PG8_SA(0, 0), cA, voffA); PG8_STAGE(PG8_SB(0, 1), cB + hstep, voffB); PG8_STAGE(PG8_SA(0, 1), cA + hstep, voffA);
        if (wr == 1) PG8_BAR;
        PG8_WAIT_V(4); PG8_BAR;
        PG8_STAGE(PG8_SB(1, 0), cB + kstep, voffB); PG8_STAGE(PG8_SA(1, 0), cA + kstep, voffA); PG8_STAGE(PG8_SB(1, 1), cB + hstep + kstep, voffB);
        PG8_WAIT_V(6); PG8_BAR;
    }
    for (;;) {
        const bool has_next = S.next(ui + 1, nxt);
        const char* nA = has_next ? (const char*)g.A + (size_t)nxt.pm * tstep : cA; const char* nB = has_next ? (const char*)g.Bt + (size_t)nxt.pn * tstep : cB;
        for (int t = 0; t < nt; t += 2) {
            const bool last = (t == nt - 2);
            const char* a1 = cA + (size_t)(t + 1) * kstep;
            const char* a2 = last ? nA : cA + (size_t)(t + 2) * kstep; const char* b2 = last ? nB : cB + (size_t)(t + 2) * kstep;
            const char* a3 = a2 + kstep; const char* b3 = b2 + kstep;
            if (last && has_next) S.a_ready(nxt);
            if constexpr (SP2) {
            PG8_LDB(B0, 0, 0); PG8_LDB(B1, 0, 1); PG8_SCHED; PG8_LDA(At, 0, 0); PG8_STAGE(PG8_SA(1, 1), a1 + hstep, voffA);
            PG8_WAIT_V(8); PG8_WAIT_L(0); PG8_BAR; PG8_MMA(0, 0, At, B0); PG8_MMA(0, 1, At, B1); PG8_BAR; PG8_SCHED;
            PG8_LDA(At, 0, 1); PG8_STAGE(PG8_SB(0, 0), b2, voffB); PG8_STAGE(PG8_SB(0, 1), b2 + hstep, voffB); PG8_STAGE(PG8_SA(0, 0), a2, voffA);
            PG8_WAIT_V(8); PG8_WAIT_L(0); PG8_BAR; PG8_MMA(1, 0, At, B0); PG8_MMA(1, 1, At, B1); PG8_BAR; PG8_SCHED;
            PG8_LDB(B0, 1, 0); PG8_LDB(B1, 1, 1); PG8_SCHED; PG8_LDA(At, 1, 0); PG8_STAGE(PG8_SA(0, 1), a2 + hstep, voffA);
            PG8_WAIT_V(8); PG8_WAIT_L(0); PG8_BAR; PG8_MMA(0, 0, At, B0); PG8_MMA(0, 1, At, B1); PG8_BAR; PG8_SCHED;
            PG8_LDA(At, 1, 1); PG8_STAGE(PG8_SB(1, 0), b3, voffB); PG8_STAGE(PG8_SB(1, 1), b3 + hstep, voffB); PG8_STAGE(PG8_SA(1, 0), a3, voffA);
            PG8_WAIT_V(8); PG8_WAIT_L(0); PG8_BAR; PG8_MMA(1, 0, At, B0); PG8_MMA(1, 1, At, B1); PG8_BAR; PG8_SCHED;
            } else {
            PG8_LDB(B0, 0, 0); PG8_SCHED; PG8_LDA(At, 0, 0); PG8_STAGE(PG8_SA(1, 1), a1 + hstep, voffA);
            PG8_WAIT_L(8); PG8_BAR; PG8_WAIT_L(0); PG8_MMA(0, 0, At, B0); PG8_BAR; PG8_SCHED;
            PG8_LDB(B1, 0, 1); PG8_STAGE(PG8_SB(0, 0), b2, voffB);
            PG8_BAR; PG8_WAIT_L(0); PG8_MMA(0, 1, At, B1); PG8_BAR;
            PG8_LDA(At, 0, 1); PG8_STAGE(PG8_SA(0, 0), a2, voffA);
            PG8_BAR; PG8_WAIT_L(0); PG8_MMA(1, 0, At, B0); PG8_BAR; PG8_SCHED;
            PG8_STAGE(PG8_SB(0, 1), b2 + hstep, voffB);
            PG8_WAIT_V(6); PG8_BAR; PG8_MMA(1, 1, At, B1); PG8_BAR;
            PG8_LDB(B0, 1, 0); PG8_SCHED; PG8_LDA(At, 1, 0); PG8_STAGE(PG8_SA(0, 1), a2 + hstep, voffA);
            PG8_WAIT_L(8); PG8_BAR; PG8_WAIT_L(0); PG8_MMA(0, 0, At, B0); PG8_BAR; PG8_SCHED;
            PG8_LDB(B1, 1, 1); PG8_STAGE(PG8_SB(1, 0), b3, voffB);
            PG8_BAR; PG8_WAIT_L(0); PG8_MMA(0, 1, At, B1); PG8_BAR;
            PG8_LDA(At, 1, 1); PG8_STAGE(PG8_SA(1, 0), a3, voffA);
            PG8_BAR; PG8_WAIT_L(0); PG8_MMA(1, 0, At, B0); PG8_BAR; PG8_SCHED;
            PG8_STAGE(PG8_SB(1, 1), b3 + hstep, voffB);
            PG8_WAIT_V(6); PG8_BAR; PG8_MMA(1, 1, At, B1); PG8_BAR;
            }
        }
        if constexpr (ALIGN_EPI) { if (wr == 0) PG8_BAR; }
        if constexpr (!Epi::AFTER_DRAIN) { E(acc, cur, wr, wc, fr, fq); S.done(cur); }
        if (!has_next) break;
#pragma unroll
        for (int a = 0; a < 2; ++a)
#pragma unroll
            for (int b = 0; b < 2; ++b)
#pragma unroll
                for (int m = 0; m < 4; ++m)
#pragma unroll
                    for (int n = 0; n < 2; ++n) acc[a][b][m][n] = (f32x4){0.f, 0.f, 0.f, 0.f};
        cur = nxt; cA = nA; cB = nB; ++ui;
        if constexpr (ALIGN_EPI) { if (wr == 1) PG8_BAR; }
    }
    PG8_WAIT_V(0);
    if constexpr (!ALIGN_EPI) { if (wr == 0) PG8_BAR; }
    PG8_BAR;
    if constexpr (Epi::AFTER_DRAIN) { E.fused(acc, cur, wr, wc, fr, fq, lds, wid, lane); S.done(cur); }
#undef PG8_SA
#undef PG8_SB
#undef PG8_STAGE
#undef PG8_LDA
#undef PG8_LDB
#undef PG8_MMA
#undef PG8_WAIT_V
#undef PG8_WAIT_L
#undef PG8_BAR
#undef PG8_SCHED
}
}

typedef pg8::Unit Unit;
typedef f32x4 Acc[2][2][4][2];

__device__ __forceinline__ void load_rs(const float* ssq, const Unit& u, int wr, int fr, int fq, float (&rs)[2][4]) {
#pragma unroll
    for (int ai = 0; ai < 2; ++ai)
#pragma unroll
        for (int m = 0; m < 4; ++m) { const int row = u.pm * 256 + ai * 128 + wr * 64 + m * 16 + fr;
            const f32x4 p = *(const f32x4*)(ssq + (size_t)row * 16 + 4 * fq); float s = (p.x + p.y) + (p.z + p.w);
            s += __shfl_xor(s, 16); s += __shfl_xor(s, 32); rs[ai][m] = rsqrtf(s * (1.0f / D) + EPS); }
}
template <int ACT, int SPLIT> struct EpiBf16S {
    static constexpr bool PERM = true, AFTER_DRAIN = false;
    const float* ssq; bf16* O; int ldc; bf16 *Q, *K, *V, *Gt;
    __device__ __forceinline__ void operator()(const Acc& acc, const Unit& u, int wr, int wc, int fr, int fq) const {
        float rs[2][4]; load_rs(ssq, u, wr, fr, fq, rs);
        bf16* base = O; int ld = ldc, colt = u.pn * 256;
        if (SPLIT) { if (u.pn < 2) { base = Q; ld = 512; } else if (u.pn < 4) { base = K; ld = 512; colt -= 512; } else if (u.pn < 8) { base = V; ld = 1024; colt -= 1024; } else { base = Gt; ld = 1024; colt -= 2048; } }
        const int row0 = u.pm * 256 + wr * 64 + fr, col0 = colt + wc * 32 + 8 * fq;
#pragma unroll
        for (int ai = 0; ai < 2; ++ai)
#pragma unroll
            for (int m = 0; m < 4; ++m) { bf16* rowp = base + (size_t)(row0 + ai * 128 + m * 16) * ld + col0; const float s = rs[ai][m];
#pragma unroll
                for (int bj = 0; bj < 2; ++bj) { f32x4 v0 = acc[ai][bj][m][0] * s, v1 = acc[ai][bj][m][1] * s;
                    if (ACT == 1) {
#pragma unroll
                        for (int e = 0; e < 4; ++e) { const float a = fmaxf(v0[e], 0.f), b = fmaxf(v1[e], 0.f); v0[e] = a * a; v1[e] = b * b; } }
                    u32x4 w; w.x = cvtpk(v0[0], v0[1]); w.y = cvtpk(v0[2], v0[3]); w.z = cvtpk(v1[0], v1[1]); w.w = cvtpk(v1[2], v1[3]);
                    *(u32x4*)(rowp + bj * 128) = w; } }
    }
};
struct EpiResid {
    static constexpr bool PERM = true, AFTER_DRAIN = false;
    const float* base; float* out; bf16* hb; float* ssq;
    __device__ __forceinline__ void operator()(const Acc& acc, const Unit& u, int wr, int wc, int fr, int fq) const {
        const int row0 = u.pm * 256 + wr * 64 + fr, col0 = u.pn * 256 + wc * 32 + 8 * fq;
#pragma unroll
        for (int ai = 0; ai < 2; ++ai)
#pragma unroll
            for (int m = 0; m < 4; ++m) { const int row = row0 + ai * 128 + m * 16; const size_t off = (size_t)row * D + col0; float ss = 0.f;
#pragma unroll
                for (int bj = 0; bj < 2; ++bj) { const f32x4 b0 = *(const f32x4*)(base + off + bj * 128), b1 = *(const f32x4*)(base + off + bj * 128 + 4);
                    const f32x4 v0 = acc[ai][bj][m][0] + b0, v1 = acc[ai][bj][m][1] + b1;
                    *(f32x4*)(out + off + bj * 128) = v0; *(f32x4*)(out + off + bj * 128 + 4) = v1;
                    u32x4 w; w.x = cvtpk(v0[0], v0[1]); w.y = cvtpk(v0[2], v0[3]); w.z = cvtpk(v1[0], v1[1]); w.w = cvtpk(v1[2], v1[3]);
                    *(u32x4*)(hb + off + bj * 128) = w;
                    ss += (v0[0] * v0[0] + v0[1] * v0[1]) + (v0[2] * v0[2] + v0[3] * v0[3]) + (v1[0] * v1[0] + v1[1] * v1[1]) + (v1[2] * v1[2] + v1[3] * v1[3]); }
                ss += __shfl_xor(ss, 16); ss += __shfl_xor(ss, 32);
                if (fq == 0) ssq[(size_t)row * 16 + u.pn * 4 + wc] = ss; }
    }
};

template <class Epi> __device__ __forceinline__ void gemm_slow(const Ctx& F, const bf16* A, const bf16* Bt, int Mr, int N, int K, const Epi& E) {
    const int wr = F.wave >> 2, wc = F.wave & 3, fr = F.lane & 15, fq = F.lane >> 4;
    const int nM = Mr / 256, nN = N / 256;
    for (int un = F.bid; un < nM * nN; un += F.G) {
        Unit u; u.pm = un / nN; u.pn = un % nN;
        Acc acc;
#pragma unroll
        for (int a = 0; a < 2; ++a)
#pragma unroll
            for (int b = 0; b < 2; ++b)
#pragma unroll
                for (int m = 0; m < 4; ++m)
#pragma unroll
                    for (int n = 0; n < 2; ++n) acc[a][b][m][n] = (f32x4){0.f, 0.f, 0.f, 0.f};
        const bf16* ap = A + (size_t)(u.pm * 256 + wr * 64 + fr) * K + 8 * fq;
        const bf16* bp0 = Bt + (size_t)(u.pn * 256 + wc * 32 + perm32(fr)) * K + 8 * fq;
        const bf16* bp1 = Bt + (size_t)(u.pn * 256 + wc * 32 + perm32(16 + fr)) * K + 8 * fq;
        for (int k0 = 0; k0 < K; k0 += 32) {
            bf16x8 a[2][4], b[2][2];
#pragma unroll
            for (int ai = 0; ai < 2; ++ai)
#pragma unroll
                for (int m = 0; m < 4; ++m) a[ai][m] = *(const bf16x8*)(ap + (size_t)(ai * 128 + m * 16) * K + k0);
#pragma unroll
            for (int bj = 0; bj < 2; ++bj) { b[bj][0] = *(const bf16x8*)(bp0 + (size_t)(bj * 128) * K + k0); b[bj][1] = *(const bf16x8*)(bp1 + (size_t)(bj * 128) * K + k0); }
#pragma unroll
            for (int ai = 0; ai < 2; ++ai)
#pragma unroll
                for (int bj = 0; bj < 2; ++bj)
#pragma unroll
                    for (int m = 0; m < 4; ++m)
#pragma unroll
                        for (int n = 0; n < 2; ++n) acc[ai][bj][m][n] = __builtin_amdgcn_mfma_f32_16x16x32_bf16(b[bj][n], a[ai][m], acc[ai][bj][m][n], 0, 0, 0);
        }
        E(acc, u, wr, wc, fr, fq);
    }
}


#ifndef USE_SLOW_GEMM
#define USE_SLOW_GEMM 0
#endif
template <class Epi> __device__ __forceinline__ void gemm_run(const Ctx& F, const bf16* A, const bf16* Bt, int Mr, int N, int K, const Epi& E) {
#if USE_SLOW_GEMM
    gemm_slow(F, A, Bt, Mr, N, K, E);
#else
    pg8::Gemm g{A, Bt, Mr, N, K}; pg8::StaticOrder S; S.init(Mr, N, F.G, F.bid);
    pg8::gemm_phase<Epi, pg8::StaticOrder, true, true>(F.lds, g, S, E);
#endif
}
__device__ __forceinline__ f32x4 skinny_task(const bf16* A, int lda, const bf16* Bt, int ldb, int K, int lane) {
    const int fr = lane & 15, fq = lane >> 4;
    const bf16* ap = A + (size_t)fr * lda + 8 * fq; const bf16* bp = Bt + (size_t)fr * ldb + 8 * fq;
    f32x4 acc = {0.f, 0.f, 0.f, 0.f};
#pragma unroll 8
    for (int k = 0; k < K; k += 32) { const bf16x8 a = *(const bf16x8*)(ap + k), b = *(const bf16x8*)(bp + k); acc = __builtin_amdgcn_mfma_f32_16x16x32_bf16(b, a, acc, 0, 0, 0); }
    return acc;
}
__device__ __forceinline__ float meta_rs(const float* ssqm, int lane) {
    const int fr = lane & 15, fq = lane >> 4; const f32x4* p = (const f32x4*)(ssqm + fr * 64 + 16 * fq); float s = 0.f;
#pragma unroll
    for (int j = 0; j < 4; ++j) { const f32x4 v = p[j]; s += (v.x + v.y) + (v.z + v.w); }
    s += __shfl_xor(s, 16); s += __shfl_xor(s, 32); return rsqrtf(s * (1.0f / D) + EPS);
}
__device__ __forceinline__ int meta_task_id(const Ctx& F) { return F.wave * F.G + F.bid; }
template <int ACT> __device__ __forceinline__ void meta_scale_gemm(const Ctx& F, const bf16* Wt, int N, int K, bf16* O) {
    const bf16* hbm = F.wsb(WS_META + MT_HBM); const float* ssqm = F.wsf(WS_META + MT_SSQM);
    for (int t = meta_task_id(F); t < N / 16; t += F.G * NWAVES) {
        const float rs = meta_rs(ssqm, F.lane); f32x4 acc = skinny_task(hbm, D, Wt + (size_t)t * 16 * K, K, K, F.lane) * rs;
        if (ACT == 1) {
#pragma unroll
            for (int e = 0; e < 4; ++e) { const float a = fmaxf(acc[e], 0.f); acc[e] = a * a; } }
        u32x2 o; o.x = cvtpk(acc[0], acc[1]); o.y = cvtpk(acc[2], acc[3]);
        *(u32x2*)(O + (size_t)(F.lane & 15) * N + t * 16 + 4 * (F.lane >> 4)) = o;
    }
}
__device__ __forceinline__ void meta_resid_gemm(const Ctx& F, const bf16* A16, int K, const bf16* Wt, const float* base) {
    float* hm = F.wsf(WS_META + MT_HM); bf16* hbm = F.wsb(WS_META + MT_HBM); float* ssqm = F.wsf(WS_META + MT_SSQM);
    for (int t = meta_task_id(F); t < D / 16; t += F.G * NWAVES) {
        const int fr = F.lane & 15, fq = F.lane >> 4; const size_t off = (size_t)fr * D + t * 16 + 4 * fq;
        f32x4 acc = skinny_task(A16, K, Wt + (size_t)t * 16 * K, K, K, F.lane);
        const f32x4 v = acc + *(const f32x4*)(base + off);
        *(f32x4*)(hm + off) = v; u32x2 o; o.x = cvtpk(v[0], v[1]); o.y = cvtpk(v[2], v[3]);
        float ss = (v[0] * v[0] + v[1] * v[1]) + (v[2] * v[2] + v[3] * v[3]); ss += __shfl_xor(ss, 16); ss += __shfl_xor(ss, 32);
        *(u32x2*)(hbm + off) = o; if (fq == 0) ssqm[fr * 64 + t] = ss;
    }
}

template <int W> __device__ __forceinline__ void pool_block(const Ctx& F, float (&pw)[47], int t0s, int c, bf16* mixrow0, bool meta_unit) {
#pragma unroll
    for (int i = 0; i < 32; ++i) {
        float s = 0.f;
#pragma unroll
        for (int j = 0; j < W; ++j) s += pw[15 + i - j];
        const int tg = t0s + i + NMETA; const int cnt = tg + 1 < W ? tg + 1 : W;
        const float v = s * (1.0f / (float)cnt) - pw[15 + i];
        const bool st = meta_unit ? (i < 16) : true;
        if (st) mixrow0[(size_t)i * D + 512 + c] = f2bf(v);
    }
}
__device__ __forceinline__ void phase_convpool(const Ctx& F) {
    const int c = F.tid;
    const float* cw = F.in[7]; float w[31];
#pragma unroll
    for (int j = 0; j < 31; ++j) w[j] = cw[j * 512 + c];
    const float cb = F.in[8][c];
    const float* lng = F.in[9]; const float* lnb = F.in[10];
    const bf16* Z0 = F.wsb(WS_Z0); const bf16* ZM = F.wsb(WS_META + MT_ZM);
    bf16* MIX0 = F.wsb(WS_MIX0); bf16* MIXM = F.wsb(WS_META + MT_MIXM);
    LAS float* Y = (LAS float*)F.lds;
    const int g = c >> 7;
    for (int un = F.bid; un < 257; un += F.G) {
        const bool meta_unit = un == 256; const int b = meta_unit ? 0 : un >> 6; const int t0 = meta_unit ? -16 : (un & 63) * 64;
        float win[62], pw[47];
        for (int sb = 0; sb < (meta_unit ? 1 : 2); ++sb) {
            const int t0s = t0 + 32 * sb;
#pragma unroll
            for (int j = 0; j < 62; ++j) {
                if (sb == 1 && j < 30) { win[j] = win[j + 32]; continue; }
                const int t = t0s - 30 + j; float v = 0.f;
                if (t >= -NMETA) { const bf16* zr = t >= 0 ? Z0 + ((size_t)b * SEQ + t) * ZN0 : ZM + (size_t)(t + NMETA) * ZN0; v = bf2f(zr[c]) * sigmoidf_(bf2f(zr[512 + c])); }
                win[j] = v;
            }
#pragma unroll
            for (int j = 0; j < 47; ++j) {
                if (sb == 1 && j < 15) { pw[j] = pw[j + 32]; continue; }
                const int t = t0s - 15 + j; float v = 0.f;
                if (t >= -NMETA) { const bf16* zr = t >= 0 ? Z0 + ((size_t)b * SEQ + t) * ZN0 : ZM + (size_t)(t + NMETA) * ZN0; v = bf2f(zr[1024 + c]); }
                pw[j] = v;
            }
#pragma unroll
            for (int i = 0; i < 32; ++i) { float y = cb;
#pragma unroll
                for (int j = 0; j < 31; ++j) y = fmaf(w[j], win[i + j], y);
                Y[i * 512 + c] = y; }
            __syncthreads();
#pragma unroll
            for (int rr = 0; rr < 4; ++rr) {
                const int i = F.wave * 4 + rr; const int t = t0s + i;
                const f32x4 y0 = *(const LAS f32x4*)(Y + i * 512 + 8 * F.lane), y1 = *(const LAS f32x4*)(Y + i * 512 + 8 * F.lane + 4);
                const float mean = wave_sum((y0.x + y0.y) + (y0.z + y0.w) + (y1.x + y1.y) + (y1.z + y1.w)) * (1.0f / 512.0f);
                const f32x4 d0 = y0 - mean, d1 = y1 - mean;
                const float var = wave_sum((d0.x * d0.x + d0.y * d0.y) + (d0.z * d0.z + d0.w * d0.w) + (d1.x * d1.x + d1.y * d1.y) + (d1.z * d1.z + d1.w * d1.w)) * (1.0f / 512.0f);
                const float rstd = rsqrtf(var + EPS);
                const f32x4 g0 = *(const f32x4*)(lng + 8 * F.lane), g1 = *(const f32x4*)(lng + 8 * F.lane + 4), b0 = *(const f32x4*)(lnb + 8 * F.lane), b1 = *(const f32x4*)(lnb + 8 * F.lane + 4);
                f32x4 o0, o1;
#pragma unroll
                for (int e = 0; e < 4; ++e) { o0[e] = siluf_(d0[e] * rstd * g0[e] + b0[e]); o1[e] = siluf_(d1[e] * rstd * g1[e] + b1[e]); }
                u32x4 wv; wv.x = cvtpk(o0[0], o0[1]); wv.y = cvtpk(o0[2], o0[3]); wv.z = cvtpk(o1[0], o1[1]); wv.w = cvtpk(o1[2], o1[3]);
                const bool st = meta_unit ? (t < 0) : true;
                bf16* orow = t >= 0 ? MIX0 + ((size_t)b * SEQ + t) * D : MIXM + (size_t)(t + NMETA) * D;
                if (st) *(u32x4*)(orow + 8 * F.lane) = wv;
            }
            {
                bf16* mixrow0 = t0s >= 0 ? MIX0 + ((size_t)b * SEQ + t0s) * D : MIXM + (size_t)(t0s + NMETA) * D;
                if (g == 0) pool_block<2>(F, pw, t0s, c, mixrow0, meta_unit);
                else if (g == 1) pool_block<4>(F, pw, t0s, c, mixrow0, meta_unit);
                else if (g == 2) pool_block<8>(F, pw, t0s, c, mixrow0, meta_unit);
                else pool_block<16>(F, pw, t0s, c, mixrow0, meta_unit);
            }
            __syncthreads();
        }
    }
}

__device__ __forceinline__ void phase_prep(const Ctx& F) {
    const int kc = F.tid;
    const float* w2p = F.in[15]; float w2[16];
#pragma unroll
    for (int j = 0; j < 16; ++j) w2[j] = w2p[j * 512 + kc];
    const float gb = F.in[16][kc];
    LAS float* rl = (LAS float*)F.lds;
    for (int un = F.bid; un < 257; un += F.G) {
        const bool meta_unit = un == 256; const int nv = meta_unit ? 16 : 64;
        const size_t row0 = meta_unit ? 0 : (size_t)un * 64;
        const float* Rp = meta_unit ? F.wsf(WS_META + MT_RM) : F.wsf(WS_R) + row0 * 16;
        const bf16* Kp = meta_unit ? F.wsb(WS_META + MT_KM) : F.wsb(WS_K) + row0 * 512;
        const bf16* Vp = meta_unit ? F.wsb(WS_META + MT_VM) : F.wsb(WS_V) + row0 * 1024;
        bf16* KDT = meta_unit ? F.wsb(WS_META + MT_KDTM) : F.wsb(WS_KDT) + (size_t)un * 512 * 64;
        bf16* VT = meta_unit ? F.wsb(WS_META + MT_VTM) : F.wsb(WS_VT) + (size_t)un * 1024 * 64;
        __syncthreads();
        for (int i = F.tid; i < nv * 16; i += NTHREADS) rl[i] = Rp[i];
        __syncthreads();
        float cum[64]; float run = 0.f;
#pragma unroll
        for (int cc = 0; cc < 64; ++cc) {
            if (cc < nv) { float pre = gb;
#pragma unroll
                for (int j4 = 0; j4 < 4; ++j4) { const f32x4 r4 = *(const LAS f32x4*)(rl + cc * 16 + 4 * j4); pre = fmaf(r4.x, w2[4 * j4], pre); pre = fmaf(r4.y, w2[4 * j4 + 1], pre); pre = fmaf(r4.z, w2[4 * j4 + 2], pre); pre = fmaf(r4.w, w2[4 * j4 + 3], pre); }
                run += logsigmoidf_(pre) * (1.0f / 16.0f); }
            cum[cc] = run;
        }
        const float tot = run;
        if (!meta_unit) F.wsf(WS_DTOT)[(size_t)un * 512 + kc] = __expf(tot);
        float kd[64];
#pragma unroll
        for (int cc = 0; cc < 64; ++cc) kd[cc] = cc < nv ? bf2f(Kp[(size_t)cc * 512 + kc]) * __expf(tot - cum[cc]) : 0.f;
#pragma unroll
        for (int q8 = 0; q8 < 8; ++q8) { u32x4 o; o.x = cvtpk(kd[8 * q8], kd[8 * q8 + 1]); o.y = cvtpk(kd[8 * q8 + 2], kd[8 * q8 + 3]); o.z = cvtpk(kd[8 * q8 + 4], kd[8 * q8 + 5]); o.w = cvtpk(kd[8 * q8 + 6], kd[8 * q8 + 7]);
            *(u32x4*)(KDT + (size_t)kc * 64 + 8 * q8) = o; }
#pragma unroll
        for (int h2 = 0; h2 < 2; ++h2) { const int vv = kc + 512 * h2; unsigned short tv[64];
#pragma unroll
            for (int cc = 0; cc < 64; ++cc) tv[cc] = cc < nv ? Vp[(size_t)cc * 1024 + vv] : (unsigned short)0;
#pragma unroll
            for (int q8 = 0; q8 < 8; ++q8) { u32x4 o; o.x = tv[8 * q8] | ((unsigned)tv[8 * q8 + 1] << 16); o.y = tv[8 * q8 + 2] | ((unsigned)tv[8 * q8 + 3] << 16); o.z = tv[8 * q8 + 4] | ((unsigned)tv[8 * q8 + 5] << 16); o.w = tv[8 * q8 + 6] | ((unsigned)tv[8 * q8 + 7] << 16);
                *(u32x4*)(VT + (size_t)vv * 64 + 8 * q8) = o; } }
    }
}

struct ScanLd { bf16x8 ka0, ka1, vb0, vb1; bf16x4 q[4]; f32x4 d; };
__device__ __forceinline__ void scan_load(ScanLd& L, const bf16* kdt_row, const bf16* vt_row, const bf16* qp, const float* dp, bool real, int fq) {
    L.ka0 = *(const bf16x8*)(kdt_row + 8 * fq); L.ka1 = *(const bf16x8*)(kdt_row + 32 + 8 * fq);
    L.vb0 = *(const bf16x8*)(vt_row + 8 * fq); L.vb1 = *(const bf16x8*)(vt_row + 32 + 8 * fq);
    if (real) {
#pragma unroll
        for (int ct = 0; ct < 4; ++ct) L.q[ct] = *(const bf16x4*)(qp + (size_t)(ct * 16) * 512);
        L.d = *(const f32x4*)dp;
    } else {
#pragma unroll
        for (int ct = 0; ct < 4; ++ct) L.q[ct] = (bf16x4){0, 0, 0, 0};
        L.d = (f32x4){0.f, 0.f, 0.f, 0.f};
    }
}
__device__ __forceinline__ void phase_scan(const Ctx& F) {
    const int fr = F.lane & 15, fq = F.lane >> 4, w = F.wave;
    constexpr int PSTR = 68;
    LAS float* part = (LAS float*)F.lds;
    for (int un = F.bid; un < 256; un += F.G) {
        const int b = un >> 6, h = (un >> 4) & 3, vs = un & 15;
        const int krow = h * 128 + 16 * w + fr;
        const int vrow = h * 256 + vs * 16 + fr;
        const bf16* KDTM = F.wsb(WS_META + MT_KDTM); const bf16* VTM = F.wsb(WS_META + MT_VTM);
        const bf16* KDT = F.wsb(WS_KDT) + (size_t)b * NCH * 512 * 64; const bf16* VT = F.wsb(WS_VT) + (size_t)b * NCH * 1024 * 64;
        const bf16* Qb = F.wsb(WS_Q) + (size_t)b * SEQ * 512 + h * 128 + 16 * w + 4 * fq;
        const float* DT = F.wsf(WS_DTOT) + (size_t)b * NCH * 512 + h * 128 + 16 * w + 4 * fq;
        bf16* Ob = F.wsb(WS_O) + (size_t)b * SEQ * D + h * 256 + vs * 16;
        f32x4 S = {0.f, 0.f, 0.f, 0.f};
        ScanLd cur, nxt;
        scan_load(cur, KDTM + (size_t)krow * 64, VTM + (size_t)vrow * 64, nullptr, nullptr, false, fq);
        for (int st = 0; st <= NCH; ++st) {
            if (st < NCH) { const int n = st;
                scan_load(nxt, KDT + ((size_t)n * 512 + krow) * 64, VT + ((size_t)n * 1024 + vrow) * 64, Qb + (size_t)(n * 64 + fr) * 512, DT + (size_t)n * 512, true, fq); }
            S = S * cur.d;
            S = __builtin_amdgcn_mfma_f32_16x16x32_bf16(cur.ka0, cur.vb0, S, 0, 0, 0);
            S = __builtin_amdgcn_mfma_f32_16x16x32_bf16(cur.ka1, cur.vb1, S, 0, 0, 0);
            if (st > 0) {
                const int n = st - 1; const int pb = st & 1;
                u32x2 sb2; sb2.x = cvtpk(S[0], S[1]); sb2.y = cvtpk(S[2], S[3]); const bf16x4 sb = __builtin_bit_cast(bf16x4, sb2);
                LAS float* pw = part + ((size_t)(pb * 8 + w) * 16 + fr) * PSTR + 4 * fq;
#pragma unroll
                for (int ct = 0; ct < 4; ++ct) { const f32x4 o = __builtin_amdgcn_mfma_f32_16x16x16bf16_1k(cur.q[ct], sb, (f32x4){0.f, 0.f, 0.f, 0.f}, 0, 0, 0);
                    *(LAS f32x4*)(pw + ct * 16) = o; }
                __syncthreads();
                const int c = F.tid >> 3, v2 = (F.tid & 7) * 2; float s0 = 0.f, s1 = 0.f;
#pragma unroll
                for (int ww = 0; ww < 8; ++ww) { const LAS float* pr = part + ((size_t)(pb * 8 + ww) * 16 + v2) * PSTR + c; s0 += pr[0]; s1 += pr[PSTR]; }
                *(unsigned*)(Ob + (size_t)(n * 64 + c) * D + v2) = cvtpk(s0, s1);
            }
            cur = nxt;
        }
        __syncthreads();
    }
}

__device__ __forceinline__ void phase_gate(const Ctx& F) {
    const float* hg = F.in[17]; const f32x4 g4 = *(const f32x4*)(hg + 4 * F.lane);
    bf16* O = F.wsb(WS_O); const bf16* Gt = F.wsb(WS_G);
    const int gw = F.bid * NWAVES + F.wave, NGW = F.G * NWAVES;
    for (int it = gw; it < M * 4; it += NGW) {
        const size_t off = (size_t)it * 256 + 4 * F.lane;
        const u32x2 ov = *(const u32x2*)(O + off), gv = *(const u32x2*)(Gt + off);
        const float o0 = __uint_as_float(ov.x << 16), o1 = __uint_as_float(ov.x & 0xffff0000u), o2 = __uint_as_float(ov.y << 16), o3 = __uint_as_float(ov.y & 0xffff0000u);
        const float x0 = __uint_as_float(gv.x << 16), x1 = __uint_as_float(gv.x & 0xffff0000u), x2 = __uint_as_float(gv.y << 16), x3 = __uint_as_float(gv.y & 0xffff0000u);
        const float rs = rsqrtf(wave_sum((o0 * o0 + o1 * o1) + (o2 * o2 + o3 * o3)) * (1.0f / 256.0f) + EPS);
        u32x2 r; r.x = cvtpk(o0 * rs * g4.x * siluf_(x0), o1 * rs * g4.y * siluf_(x1)); r.y = cvtpk(o2 * rs * g4.z * siluf_(x2), o3 * rs * g4.w * siluf_(x3));
        *(u32x2*)(O + off) = r;
    }
}
__device__ __forceinline__ void phase_final(const Ctx& F) {
    const float* fg = F.in[19]; const float* ssq = F.wsf(WS_SSQ);
    const int gw = F.bid * NWAVES + F.wave, NGW = F.G * NWAVES;
    for (int m = gw; m < M; m += NGW) {
        float s = F.lane < 16 ? ssq[(size_t)m * 16 + F.lane] : 0.f; s = wave_sum(s);
        const float rs = rsqrtf(s * (1.0f / D) + EPS);
        f32x4* xr = (f32x4*)(F.out + (size_t)m * D) + F.lane;
#pragma unroll
        for (int j = 0; j < 4; ++j) { const f32x4 g = *((const f32x4*)fg + F.lane + 64 * j); f32x4 v = xr[64 * j]; v = v * rs * g; xr[64 * j] = v; }
    }
}
__device__ __forceinline__ void phase_r(const Ctx& F) {
    const bf16* Wr = F.wsb(WS_W_IN1) + (size_t)GN * D; const bf16* hb = F.wsb(WS_HB); const float* ssq = F.wsf(WS_SSQ); float* R = F.wsf(WS_R);
    const int gw = F.bid * NWAVES + F.wave, NGW = F.G * NWAVES;
    for (int t = gw; t < M / 16; t += NGW) {
        const int fr = F.lane & 15, fq = F.lane >> 4; const int row = t * 16 + fr;
        const f32x4 p = *(const f32x4*)(ssq + (size_t)row * 16 + 4 * fq); float s = (p.x + p.y) + (p.z + p.w); s += __shfl_xor(s, 16); s += __shfl_xor(s, 32);
        const float rs = rsqrtf(s * (1.0f / D) + EPS);
        const f32x4 acc = skinny_task(hb + (size_t)t * 16 * D, D, Wr, D, D, F.lane) * rs;
        *(f32x4*)(R + (size_t)row * 16 + 4 * fq) = acc;
    }
}
__device__ __forceinline__ void meta_in1(const Ctx& F) {
    const bf16* hbm = F.wsb(WS_META + MT_HBM); const float* ssqm = F.wsf(WS_META + MT_SSQM); const bf16* Wt = F.wsb(WS_W_IN1);
    for (int t = meta_task_id(F); t < (GNR - 512) / 16; t += F.G * NWAVES) {
        const int n0 = 512 + t * 16; if (n0 >= 2048 && n0 < GN) continue;
        const int fr = F.lane & 15, fq = F.lane >> 4;
        const float rs = meta_rs(ssqm, F.lane); const f32x4 acc = skinny_task(hbm, D, Wt + (size_t)n0 * D, D, D, F.lane) * rs;
        u32x2 o; o.x = cvtpk(acc[0], acc[1]); o.y = cvtpk(acc[2], acc[3]);
        if (n0 < 1024) *(u32x2*)(F.wsb(WS_META + MT_KM) + (size_t)fr * 512 + (n0 - 512) + 4 * fq) = o;
        else if (n0 < 2048) *(u32x2*)(F.wsb(WS_META + MT_VM) + (size_t)fr * 1024 + (n0 - 1024) + 4 * fq) = o;
        else *(f32x4*)(F.wsf(WS_META + MT_RM) + fr * 16 + 4 * fq) = acc;
    }
}


constexpr int CW_BAR = 4096;
constexpr int LDSCTL_OFF = 131072, MISC_OFF = LDSCTL_OFF + 320;
#define XB_TMO      128
#define XB_XCNT(j)  (256  + 64 * (j))
#define XB_XSUB(j)  (1280 + 64 * (j))
#define XB_XGEN(j)  (2304 + 64 * (j))
#define XB_TOP      3328
#define XB_TOPGEN   3392
#define XCD_BAR_WORDS 3456
#define XB_SPIN_CAP (1u << 18)
__device__ __forceinline__ unsigned xb_ld(unsigned* p)              { return __hip_atomic_load(p, __ATOMIC_RELAXED, __HIP_MEMORY_SCOPE_AGENT); }
__device__ __forceinline__ unsigned xb_add(unsigned* p, unsigned v) { return __hip_atomic_fetch_add(p, v, __ATOMIC_RELAXED, __HIP_MEMORY_SCOPE_AGENT); }
__device__ __forceinline__ unsigned xb_xcc_id() { return (unsigned)__builtin_amdgcn_s_getreg((3 << 11) | 20) & 0xFu; }
#define XB_SPIN(cond, bar) do { unsigned _sp = 0; while (cond) { __builtin_amdgcn_s_sleep(1); \
    if ((++_sp & 255u) == 0u) { if (xb_ld(&(bar)[XB_TMO])) break; if (_sp > XB_SPIN_CAP) { atomicAdd(&(bar)[XB_TMO], 1u); break; } } } } while (0)
struct XcdBarrier { unsigned* bar; unsigned x; volatile LAS unsigned* st; };
__device__ __forceinline__ XcdBarrier xcd_barrier_post(unsigned* bar, volatile LAS unsigned* st) {
    XcdBarrier b; b.bar = bar; b.x = xb_xcc_id(); b.st = st;
    if (threadIdx.x == 0) (void)xb_add(&bar[XB_XCNT(b.x)], 1u);
    return b;
}
__device__ __forceinline__ void xcd_barrier_complete(unsigned* bar, unsigned x, unsigned& nloc, unsigned& nx) {
    const unsigned G = gridDim.x * gridDim.y * gridDim.z;
    unsigned sum, cnt, mine, sp = 0u;
    for (;;) {
        sum = 0u; cnt = 0u; mine = 0u;
#pragma unroll
        for (unsigned j = 0; j < 16; ++j) { const unsigned c = xb_ld(&bar[XB_XCNT(j)]); sum += c; cnt += (c > 0u) ? 1u : 0u; mine = (j == x) ? c : mine; }
        if (sum == G) break;
        __builtin_amdgcn_s_sleep(1);
        if ((++sp & 255u) == 0u) { if (xb_ld(&bar[XB_TMO])) break; if (sp > XB_SPIN_CAP) { atomicAdd(&bar[XB_TMO], 1u); break; } }
    }
    nloc = mine > 0u ? mine : 1u; nx = cnt > 0u ? cnt : 1u;
}
__device__ __forceinline__ void xcd_barrier(const XcdBarrier& b) {
    asm volatile("s_waitcnt vmcnt(0)" ::: "memory");
    __syncthreads();
    if (threadIdx.x == 0) {
        unsigned* bar = b.bar;
        __builtin_amdgcn_s_waitcnt(0);
        unsigned nloc = b.st[0], nx = b.st[1];
        if (nloc == 0u) { xcd_barrier_complete(bar, b.x, nloc, nx); b.st[0] = nloc; b.st[1] = nx; }
        const unsigned old = xb_add(&bar[XB_XSUB(b.x)], 1u);
        const unsigned gen = old / nloc;
        if (old + 1u == (gen + 1u) * nloc) {
            __builtin_amdgcn_fence(__ATOMIC_RELEASE, "agent");
            asm volatile("s_waitcnt vmcnt(0)" ::: "memory");
            const unsigned og = xb_add(&bar[XB_TOP], 1u);
            const unsigned tg = og / nx;
            if (og + 1u == (tg + 1u) * nx) xb_add(&bar[XB_TOPGEN], 1u);
            else XB_SPIN(xb_ld(&bar[XB_TOPGEN]) == tg, bar);
            __builtin_amdgcn_fence(__ATOMIC_ACQUIRE, "agent");
            xb_add(&bar[XB_XGEN(b.x)], 1u);
            asm volatile("s_waitcnt vmcnt(0)" ::: "memory");
        } else {
            XB_SPIN(xb_ld(&bar[XB_XGEN(b.x)]) == gen, bar);
            __builtin_amdgcn_fence(__ATOMIC_ACQUIRE, "agent");
            asm volatile("s_waitcnt vmcnt(0)" ::: "memory");
        }
    }
    __syncthreads();
}

constexpr int N_PHASES = 14;
__global__ void __launch_bounds__(NTHREADS, 2) fwd_kernel(Args args) {
    extern __shared__ __attribute__((aligned(16))) unsigned char lds_raw[];
    Ctx F;
#pragma unroll
    for (int i = 0; i < 20; ++i) F.in[i] = args.in[i];
    F.out = args.out; F.ws = args.ws; F.lds = (LAS unsigned char*)lds_raw;
    F.tid = threadIdx.x; F.lane = F.tid & 63; F.wave = __builtin_amdgcn_readfirstlane(F.tid >> 6); F.G = gridDim.x; F.bid = blockIdx.x;
    const int lo = args.ph_lo, hi = args.ph_hi;
    for (int u = F.tid; u < (LDS_BYTES - LDSCTL_OFF) / 4; u += NTHREADS) ((LAS unsigned*)(F.lds + LDSCTL_OFF))[u] = 0u;
    __syncthreads();
    XcdBarrier bar = xcd_barrier_post((unsigned*)(F.ws + WS_CTL) + CW_BAR, (volatile LAS unsigned*)(F.lds + MISC_OFF) + 8);
#define IN(k) (lo <= (k) && (k) < hi)
#define SEAM(k) do { if (IN(k) && IN((k) + 1)) xcd_barrier(bar); } while (0)
    if (IN(0)) phase_prologue(F);
    SEAM(0);
    if (IN(1)) {
        meta_scale_gemm<0>(F, F.wsb(WS_W_IN0), ZN0, D, F.wsb(WS_META + MT_ZM));
        EpiBf16S<0, 0> E{F.wsf(WS_SSQ), F.wsb(WS_Z0), ZN0, nullptr, nullptr, nullptr, nullptr};
        gemm_run(F, F.wsb(WS_HB), F.wsb(WS_W_IN0), M, ZN0, D, E);
    }
    SEAM(1);
    if (IN(2)) phase_convpool(F);
    SEAM(2);
    if (IN(3)) {
        meta_resid_gemm(F, F.wsb(WS_META + MT_MIXM), D, F.wsb(WS_W_OUT0), F.in[1]);
        EpiResid E{F.in[0], F.out, F.wsb(WS_HB), F.wsf(WS_SSQ)};
        gemm_run(F, F.wsb(WS_MIX0), F.wsb(WS_W_OUT0), M, D, D, E);
    }
    SEAM(3);
    if (IN(4)) {
        meta_scale_gemm<1>(F, F.wsb(WS_W1_0), FF, D, F.wsb(WS_META + MT_AM));
        EpiBf16S<1, 0> E{F.wsf(WS_SSQ), F.wsb(WS_A), FF, nullptr, nullptr, nullptr, nullptr};
        gemm_run(F, F.wsb(WS_HB), F.wsb(WS_W1_0), M, FF, D, E);
    }
    SEAM(4);
    if (IN(5)) {
        meta_resid_gemm(F, F.wsb(WS_META + MT_AM), FF, F.wsb(WS_W2_0), F.wsf(WS_META + MT_HM));
        EpiResid E{F.out, F.out, F.wsb(WS_HB), F.wsf(WS_SSQ)};
        gemm_run(F, F.wsb(WS_A), F.wsb(WS_W2_0), M, D, FF, E);
    }
    SEAM(5);
    if (IN(6)) {
        meta_in1(F);
        phase_r(F);
        EpiBf16S<0, 1> E{F.wsf(WS_SSQ), nullptr, 0, F.wsb(WS_Q), F.wsb(WS_K), F.wsb(WS_V), F.wsb(WS_G)};
        gemm_run(F, F.wsb(WS_HB), F.wsb(WS_W_IN1), M, GN, D, E);
    }
    SEAM(6);
    if (IN(7)) phase_prep(F);
    SEAM(7);
    if (IN(8)) phase_scan(F);
    SEAM(8);
    if (IN(9)) phase_gate(F);
    SEAM(9);
    if (IN(10)) {
        EpiResid E{F.out, F.out, F.wsb(WS_HB), F.wsf(WS_SSQ)};
        gemm_run(F, F.wsb(WS_O), F.wsb(WS_W_OUT1), M, D, D, E);
    }
    SEAM(10);
    if (IN(11)) {
        EpiBf16S<1, 0> E{F.wsf(WS_SSQ), F.wsb(WS_A), FF, nullptr, nullptr, nullptr, nullptr};
        gemm_run(F, F.wsb(WS_HB), F.wsb(WS_W1_1), M, FF, D, E);
    }
    SEAM(11);
    if (IN(12)) {
        EpiResid E{F.out, F.out, F.wsb(WS_HB), F.wsf(WS_SSQ)};
        gemm_run(F, F.wsb(WS_A), F.wsb(WS_W2_1), M, D, FF, E);
    }
    SEAM(12);
    if (IN(13)) phase_final(F);
#undef IN
#undef SEAM
}

extern "C" void kernel_launch(void* const* d_in, const int* in_sizes, int n_in, void* d_out, int out_size, void* d_ws, size_t ws_size, hipStream_t stream) {
    static int grid = 0;
    if (grid == 0) {
        if (n_in != 20 || in_sizes[0] != M * D || out_size != M * D || ws_size < WS_END) { fprintf(stderr, "kernel_launch: unexpected shapes (n_in %d, in0 %d, out %d, ws %zu)\n", n_in, n_in > 0 ? in_sizes[0] : -1, out_size, ws_size); grid = -1; return; }
        int dev = 0, cus = 0, per_cu = 0;
        (void)hipGetDevice(&dev); (void)hipDeviceGetAttribute(&cus, hipDeviceAttributeMultiprocessorCount, dev);
        (void)hipFuncSetAttribute((const void*)fwd_kernel, hipFuncAttributeMaxDynamicSharedMemorySize, LDS_BYTES);
        (void)hipOccupancyMaxActiveBlocksPerMultiprocessor(&per_cu, (const void*)fwd_kernel, NTHREADS, LDS_BYTES);
        (void)hipGetLastError();
        if (per_cu < 1) per_cu = 1;
        grid = cus * (per_cu < 1 ? per_cu : 1);
    }
    if (grid < 0) return;
    (void)hipMemsetAsync((char*)d_ws + WS_CTL, 0, CTL_ZERO_BYTES, stream);
    Args a{};
    for (int i = 0; i < 20; ++i) a.in[i] = (const float*)d_in[i];
    a.out = (float*)d_out; a.ws = (unsigned char*)d_ws;
#if defined(MK_PER_PHASE)
    for (int p = 0; p < N_PHASES; ++p) { a.ph_lo = p; a.ph_hi = p + 1; hipLaunchKernelGGL(fwd_kernel, dim3(grid), dim3(NTHREADS), LDS_BYTES, stream, a); }
#else
    a.ph_lo = 0; a.ph_hi = N_PHASES; hipLaunchKernelGGL(fwd_kernel, dim3(grid), dim3(NTHREADS), LDS_BYTES, stream, a);
#endif
}
```

```cpp
#include <hip/hip_runtime.h>
#include <cstdio>
#include <cstdint>

#define LAS __attribute__((address_space(3)))
typedef unsigned short bf16;
typedef short bf16x8 __attribute__((ext_vector_type(8)));
typedef short bf16x4 __attribute__((ext_vector_type(4)));
typedef float f32x4 __attribute__((ext_vector_type(4)));
typedef float f32x2 __attribute__((ext_vector_type(2)));
typedef unsigned u32x4 __attribute__((ext_vector_type(4)));
typedef unsigned u32x2 __attribute__((ext_vector_type(2)));
typedef __bf16 bf16x2_t __attribute__((ext_vector_type(2)));

constexpr int NB = 4, SEQ = 4096, D = 1024, FF = 4096, M = NB * SEQ, NMETA = 16;
constexpr int ZN0 = 1536;
constexpr int GN = 3072, GNR = 3088;
constexpr int NCH = SEQ / 64;
constexpr float EPS = 1e-5f;
constexpr int NTHREADS = 512, NWAVES = 8;

constexpr size_t MiB = 1u << 20;
constexpr size_t WS_CTL = 0, CTL_ZERO_BYTES = 1 * MiB;
constexpr size_t WS_SSQ = 1 * MiB;
constexpr size_t WS_R = 2 * MiB;
constexpr size_t WS_DTOT = 3 * MiB;
constexpr size_t WS_META = 4 * MiB;
constexpr size_t WS_W_IN0 = 5 * MiB, WS_W_OUT0 = 8 * MiB, WS_W1_0 = 10 * MiB, WS_W2_0 = 18 * MiB;
constexpr size_t WS_W_IN1 = 26 * MiB, WS_W_OUT1 = 33 * MiB, WS_W1_1 = 35 * MiB, WS_W2_1 = 43 * MiB;
constexpr size_t WS_HB = 52 * MiB;
constexpr size_t WS_S = 84 * MiB;
constexpr size_t WS_Z0 = WS_S, WS_MIX0 = WS_S + 48 * MiB;
constexpr size_t WS_A = WS_S;
constexpr size_t WS_Q = WS_S, WS_K = WS_S + 16 * MiB, WS_V = WS_S + 32 * MiB, WS_G = WS_S + 64 * MiB;
constexpr size_t WS_KDT = WS_S + 96 * MiB, WS_VT = WS_S + 112 * MiB;
constexpr size_t WS_O = WS_V;
constexpr size_t WS_END = WS_S + 144 * MiB;
static_assert(WS_END <= 256 * MiB, "workspace map");
constexpr size_t MT_HM = 0;
constexpr size_t MT_HBM = 64 * 1024;
constexpr size_t MT_ZM = 96 * 1024;
constexpr size_t MT_MIXM = 144 * 1024;
constexpr size_t MT_AM = 176 * 1024;
constexpr size_t MT_KM = 304 * 1024;
constexpr size_t MT_VM = 320 * 1024;
constexpr size_t MT_RM = 352 * 1024;
constexpr size_t MT_SSQM = 356 * 1024;
constexpr size_t MT_KDTM = 384 * 1024;
constexpr size_t MT_VTM = 448 * 1024;
static_assert(MT_VTM + 128 * 1024 <= MiB, "meta map");

constexpr int LDS_BYTES = 147456;

__device__ __forceinline__ float bf2f(bf16 b) { return __uint_as_float((unsigned)b << 16); }
__device__ __forceinline__ unsigned cvtpk(float lo, float hi) { f32x2 v = {lo, hi}; bf16x2_t b = __builtin_convertvector(v, bf16x2_t); return __builtin_bit_cast(unsigned, b); }
__device__ __forceinline__ bf16 f2bf(float f) { return (bf16)(cvtpk(f, 0.f) & 0xffffu); }
__device__ __forceinline__ float wave_sum(float v) {
#pragma unroll
    for (int o = 1; o < 64; o <<= 1) v += __shfl_xor(v, o);
    return v;
}
__device__ __forceinline__ float sigmoidf_(float x) { return __builtin_amdgcn_rcpf(1.0f + __expf(-x)); }
__device__ __forceinline__ float siluf_(float x) { return x * sigmoidf_(x); }
__device__ __forceinline__ float logsigmoidf_(float x) { return fminf(x, 0.f) - log1pf(__expf(-fabsf(x))); }
__host__ __device__ __forceinline__ int perm32(int rho) { const int n = rho >> 4, i = rho & 15; return 8 * (i >> 2) + 4 * n + (i & 3); }

struct Args { const float* in[20]; float* out; unsigned char* ws; int ph_lo, ph_hi, probe_phase, probe_reps; };

struct Ctx {
    const float* in[20]; float* out; unsigned char* ws;
    LAS unsigned char* lds;
    int tid, lane, wave, G, bid;
    __device__ __forceinline__ bf16* wsb(size_t off) const { return (bf16*)(ws + off); }
    __device__ __forceinline__ float* wsf(size_t off) const { return (float*)(ws + off); }
};

__device__ __forceinline__ void p0_transpose_item(const float* W, int K, int N, bf16* WT, const float* ksc, int qcols, float qsc, LAS float* scr, int item, int lane) {
    const int nblk = (N + 31) / 32, kb = item / nblk, nb = item % nblk, k0 = 64 * kb, n0 = 32 * nb;
    const bool nok = (n0 + (lane & 31)) < N;
#pragma unroll 8
    for (int i = 0; i < 32; ++i) { const int kk = 2 * i + (lane >> 5); float v = nok ? W[(size_t)(k0 + kk) * N + n0 + (lane & 31)] : 0.f; if (ksc) v *= ksc[k0 + kk]; scr[kk * 33 + (lane & 31)] = v; }
    asm volatile("s_waitcnt lgkmcnt(0)" ::: "memory");
    const int c = lane & 7;
#pragma unroll
    for (int j = 0; j < 4; ++j) { const int n = (lane >> 3) + 8 * j; const LAS float* s = scr + (8 * c) * 33 + n; const float sc = (n0 + n) < qcols ? qsc : 1.0f;
        u32x4 o; o.x = cvtpk(s[0 * 33] * sc, s[1 * 33] * sc); o.y = cvtpk(s[2 * 33] * sc, s[3 * 33] * sc); o.z = cvtpk(s[4 * 33] * sc, s[5 * 33] * sc); o.w = cvtpk(s[6 * 33] * sc, s[7 * 33] * sc);
        if (n0 + n < N) *(u32x4*)(WT + (size_t)(n0 + n) * K + k0 + 8 * c) = o; }
    asm volatile("s_waitcnt lgkmcnt(0)" ::: "memory");
}
__device__ __forceinline__ void p0_fold_item(const float* pw, const float* psc, const float* wo, bf16* WT, int item, int lane) {
    const int g = item >> 9, cb = (item >> 6) & 7, nb = item & 63, fr = lane & 15, fq = lane >> 4;
    const float* pa = pw + ((size_t)g * 128 + cb * 16 + fr) * 128 + fq;
    const float* sc = psc + g * 128 + fq;
    const float* pb = wo + ((size_t)(512 + g * 128 + fq)) * D + nb * 16 + fr;
    f32x4 acc = {0.f, 0.f, 0.f, 0.f};
#pragma unroll 8
    for (int db = 0; db < 32; ++db) { const float a = pa[4 * db] * sc[4 * db]; const float b = pb[(size_t)(4 * db) * D]; acc = __builtin_amdgcn_mfma_f32_16x16x4f32(a, b, acc, 0, 0, 0); }
    u32x2 o; o.x = cvtpk(acc[0], acc[1]); o.y = cvtpk(acc[2], acc[3]);
    *(u32x2*)(WT + (size_t)(nb * 16 + fr) * D + 512 + g * 128 + cb * 16 + 4 * fq) = o;
}
__device__ __forceinline__ void p0_row(const float* xrow, bf16* orow, float* ssq, int nslots, int lane) {
    const f32x4* xr = (const f32x4*)xrow + lane;
    f32x4 v[4]; float s = 0.f;
#pragma unroll
    for (int j = 0; j < 4; ++j) { v[j] = xr[64 * j]; s += (v[j].x * v[j].x + v[j].y * v[j].y) + (v[j].z * v[j].z + v[j].w * v[j].w); }
    s = wave_sum(s);
    u32x2* o8 = (u32x2*)orow + lane;
#pragma unroll
    for (int j = 0; j < 4; ++j) { u32x2 o; o.x = cvtpk(v[j].x, v[j].y); o.y = cvtpk(v[j].z, v[j].w); o8[64 * j] = o; }
    if (lane < nslots) ssq[lane] = lane == 0 ? s : 0.f;
}
__device__ __forceinline__ void phase_prologue(const Ctx& F) {
    LAS float* scr = (LAS float*)(F.lds + F.wave * 16384);
    const int gw = F.wave * F.G + F.bid, NGW = F.G * NWAVES;
    const float* mixg = F.in[2]; const float* ffng = F.in[3];
    constexpr int I_IN0 = (D / 64) * (ZN0 / 32), I_OUT0 = (512 / 64) * (D / 32), I_W1 = (D / 64) * (FF / 32), I_W2 = (FF / 64) * (D / 32);
    constexpr int I_IN1 = (D / 64) * ((GNR + 31) / 32), I_OUT1 = (D / 64) * (D / 32), I_FOLD = 4 * 8 * 64;
    constexpr int NITEMS = I_IN0 + I_OUT0 + 2 * I_W1 + 2 * I_W2 + I_IN1 + I_OUT1 + I_FOLD;
    for (int it = gw; it < NITEMS; it += NGW) {
        int r = it;
        if (r < I_IN0) { p0_transpose_item(F.in[6], D, ZN0, F.wsb(WS_W_IN0), mixg, 0, 1.f, scr, r, F.lane); continue; } r -= I_IN0;
        if (r < I_OUT0) { p0_transpose_item(F.in[13], D, D, F.wsb(WS_W_OUT0), nullptr, 0, 1.f, scr, r, F.lane); continue; } r -= I_OUT0;
        if (r < I_W1) { p0_transpose_item(F.in[4], D, FF, F.wsb(WS_W1_0), ffng, 0, 1.f, scr, r, F.lane); continue; } r -= I_W1;
        if (r < I_W1) { p0_transpose_item(F.in[4] + (size_t)D * FF, D, FF, F.wsb(WS_W1_1), ffng + D, 0, 1.f, scr, r, F.lane); continue; } r -= I_W1;
        if (r < I_W2) { p0_transpose_item(F.in[5], FF, D, F.wsb(WS_W2_0), nullptr, 0, 1.f, scr, r, F.lane); continue; } r -= I_W2;
        if (r < I_W2) { p0_transpose_item(F.in[5] + (size_t)FF * D, FF, D, F.wsb(WS_W2_1), nullptr, 0, 1.f, scr, r, F.lane); continue; } r -= I_W2;
        if (r < I_IN1) { p0_transpose_item(F.in[14], D, GNR, F.wsb(WS_W_IN1), mixg + D, 512, 0.08838834764831845f, scr, r, F.lane); continue; } r -= I_IN1;
        if (r < I_OUT1) { p0_transpose_item(F.in[18], D, D, F.wsb(WS_W_OUT1), nullptr, 0, 1.f, scr, r, F.lane); continue; } r -= I_OUT1;
        p0_fold_item(F.in[11], F.in[12], F.in[13], F.wsb(WS_W_OUT0), r, F.lane);
    }
    for (int m = gw; m < M + NMETA; m += NGW) {
        if (m < M) p0_row(F.in[0] + (size_t)m * D, F.wsb(WS_HB) + (size_t)m * D, F.wsf(WS_SSQ) + (size_t)m * 16, 16, F.lane);
        else { const int r = m - M; p0_row(F.in[1] + (size_t)r * D, F.wsb(WS_META + MT_HBM) + (size_t)r * D, F.wsf(WS_META + MT_SSQM) + (size_t)r * 64, 64, F.lane); }
    }
}

namespace pg8 {
#define PG8_LAS __attribute__((address_space(3)))
typedef unsigned short bf16_t;
typedef short bf16x8 __attribute__((ext_vector_type(8)));
typedef float f32x4 __attribute__((ext_vector_type(4)));
typedef unsigned u32x4 __attribute__((ext_vector_type(4)));
constexpr int BM = 256, BK = 64, HALF = 128, HTB = HALF * BK * 2  , STAGE_BYTES = 8 * HTB, NXCD = 8, WGM = 8;

__host__ __device__ __forceinline__ int lds_byte(int r, int c) { const int st = (r >> 4) * 2 + (c >> 5), rr = r & 15, cc = c & 31, ob = rr * 64 + cc * 2; return st * 1024 + (ob ^ (((ob >> 9) & 1) << 5)); }
__host__ __device__ __forceinline__ void stage_rc(int b, int& R, int& C) { const int st = b / 1024, sb = b % 1024, swz = sb ^ (((sb >> 9) & 1) << 5); R = (st >> 1) * 16 + swz / 64; C = (st & 1) * 32 + (swz % 64) / 2; }
__host__ __device__ __forceinline__ int perm32(int rho) { const int n = rho >> 4, i = rho & 15; return 8 * (i >> 2) + 4 * n + (i & 3); }

struct Unit { int pm, pn; };
struct Gemm { const bf16_t* A; const bf16_t* Bt; int M, N, K; };

struct StaticOrder {
    int nM, nN, nwg, G, c;
    __host__ __device__ void init(int M, int N, int G_, int c_) { nM = M / BM; nN = N / BM; nwg = nM * nN; G = G_; c = c_; }
    __host__ __device__ bool next(int i, Unit& u) const {
        const long L = (long)i * G + c; if (L >= nwg) return false;
        int wgid = (int)L; { const int q = nwg / NXCD, r = nwg % NXCD, xcd = wgid % NXCD, off = wgid / NXCD; wgid = (xcd < r ? xcd * (q + 1) : r * (q + 1) + (xcd - r) * q) + off; }
        const int nig = WGM * nN, gid = wgid / nig, fm = gid * WGM, gsz = (nM - fm) < WGM ? (nM - fm) : WGM;
        u.pm = fm + ((wgid % nig) % gsz); u.pn = (wgid % nig) / gsz; return true;
    }
    __device__ __forceinline__ void a_ready(const Unit&) const {}
    __device__ __forceinline__ void done(const Unit&) const {}
};

template <class Epi, class Sched, bool ALIGN_EPI = false, bool SP2 = false>
__device__ __forceinline__ void gemm_phase(PG8_LAS unsigned char* lds, const Gemm g, const Sched& S, const Epi& E) {
    const int tid = threadIdx.x, wid = __builtin_amdgcn_readfirstlane(tid >> 6), lane = tid & 63, wr = wid >> 2, wc = wid & 3, fr = lane & 15, fq = lane >> 4;
    const int K = g.K, nt = K / BK;
    unsigned voffA[2], voffB[2];
#pragma unroll
    for (int i = 0; i < 2; ++i) { int R, C; stage_rc(tid * 16 + i * 8192, R, C); const int Rb = Epi::PERM ? ((R & ~31) + perm32(R & 31)) : R;
        voffA[i] = (unsigned)(R * K + C) * 2u; voffB[i] = (unsigned)(Rb * K + C) * 2u; }
    const size_t kstep = (size_t)(BK * 2);
    const size_t hstep = (size_t)HALF * K * 2;
    const size_t tstep = 2 * hstep;
    const unsigned ldsw = (unsigned)wid * 1024u;
    const int aoff = lds_byte(wr * 64 + fr, fq * 8), boff = lds_byte(wc * 32 + fr, fq * 8);
#define PG8_SA(b, h) (((b) * 2 + (h)) * HTB)
#define PG8_SB(b, h) ((4 + (b) * 2 + (h)) * HTB)
#define PG8_STAGE(bufoff, gbase, voff) do { _Pragma("unroll") for (int _i = 0; _i < 2; ++_i) \
        __builtin_amdgcn_global_load_lds((const unsigned*)((const char*)(gbase) + (voff)[_i]), (PG8_LAS unsigned*)(lds + (bufoff) + ldsw + _i * 8192), 16, 0, 0); } while (0)
#define PG8_LDA(dst, b, h) do { _Pragma("unroll") for (int m = 0; m < 4; ++m) _Pragma("unroll") for (int k = 0; k < 2; ++k) dst[m][k] = *(const PG8_LAS bf16x8*)(lds + PG8_SA(b, h) + aoff + m * 2048 + k * 1024); } while (0)
#define PG8_LDB(dst, b, h) do { _Pragma("unroll") for (int n = 0; n < 2; ++n) _Pragma("unroll") for (int k = 0; k < 2; ++k) dst[n][k] = *(const PG8_LAS bf16x8*)(lds + PG8_SB(b, h) + boff + n * 2048 + k * 1024); } while (0)
#define PG8_MMA(ai, bj, At, Bt) do { __builtin_amdgcn_s_setprio(1); _Pragma("unroll") for (int m = 0; m < 4; ++m) _Pragma("unroll") for (int n = 0; n < 2; ++n) _Pragma("unroll") for (int k = 0; k < 2; ++k) \
        acc[ai][bj][m][n] = __builtin_amdgcn_mfma_f32_16x16x32_bf16(Bt[n][k], At[m][k], acc[ai][bj][m][n], 0, 0, 0); __builtin_amdgcn_s_setprio(0); } while (0)
#define PG8_WAIT_V(n) asm volatile("s_waitcnt vmcnt(" #n ")" ::: "memory")
#define PG8_WAIT_L(n) asm volatile("s_waitcnt lgkmcnt(" #n ")" ::: "memory")
#define PG8_BAR __builtin_amdgcn_s_barrier()
#define PG8_SCHED __builtin_amdgcn_sched_barrier(0)
    Unit cur, nxt; int ui = 0;
    if (!S.next(0, cur)) return;
    f32x4 acc[2][2][4][2];
#pragma unroll
    for (int a = 0; a < 2; ++a)
#pragma unroll
        for (int b = 0; b < 2; ++b)
#pragma unroll
            for (int m = 0; m < 4; ++m)
#pragma unroll
                for (int n = 0; n < 2; ++n) acc[a][b][m][n] = (f32x4){0.f, 0.f, 0.f, 0.f};
    bf16x8 At[4][2], B0[2][2], B1[2][2];
    const char* cA = (const char*)g.A + (size_t)cur.pm * tstep; const char* cB = (const char*)g.Bt + (size_t)cur.pn * tstep;
    S.a_ready(cur);
    if constexpr (SP2) {
        PG8_STAGE(PG8_SB(0, 0), cB, voffB); PG8_STAGE(PG8_SB(0, 1), cB + hstep, voffB); PG8_STAGE(PG8_SA(0, 0), cA, voffA); PG8_STAGE(PG8_SA(0, 1), cA + hstep, voffA);
        if (wr == 1) PG8_BAR;
        PG8_WAIT_V(2); PG8_BAR;
        PG8_STAGE(PG8_SB(1, 0), cB + kstep, voffB); PG8_STAGE(PG8_SA(1, 0), cA + kstep, voffA); PG8_STAGE(PG8_SB(1, 1), cB + hstep + kstep, voffB);
        PG8_WAIT_V(6); PG8_BAR;
    } else {
        PG8_STAGE(PG8_SB(0, 0), cB, voffB); PG8_STAGE(PG8_SA(0, 0), cA, voffA); PG8_STAGE(PG8_SB(0, 1), cB + hstep, voffB); PG8_STAGE(PG8_SA(0, 1), cA + hstep, voffA);
        if (wr == 1) PG8_BAR;
        PG8_WAIT_V(4); PG8_BAR;
        PG8_STAGE(PG8_SB(1, 0), cB + kstep, voffB); PG8_STAGE(PG8_SA(1, 0), cA + kstep, voffA); PG8_STAGE(PG8_SB(1, 1), cB + hstep + kstep, voffB);
        PG8_WAIT_V(6); PG8_BAR;
    }
    for (;;) {
        const bool has_next = S.next(ui + 1, nxt);
        const char* nA = has_next ? (const char*)g.A + (size_t)nxt.pm * tstep : cA; const char* nB = has_next ? (const char*)g.Bt + (size_t)nxt.pn * tstep : cB;
        for (int t = 0; t < nt; t += 2) {
            const bool last = (t == nt - 2);
            const char* a1 = cA + (size_t)(t + 1) * kstep;
            const char* a2 = last ? nA : cA + (size_t)(t + 2) * kstep; const char* b2 = last ? nB : cB + (size_t)(t + 2) * kstep;
            const char* a3 = a2 + kstep; const char* b3 = b2 + kstep;
            if (last && has_next) S.a_ready(nxt);
            if constexpr (SP2) {
            PG8_LDB(B0, 0, 0); PG8_LDB(B1, 0, 1); PG8_SCHED; PG8_LDA(At, 0, 0); PG8_STAGE(PG8_SA(1, 1), a1 + hstep, voffA);
            PG8_WAIT_V(8); PG8_WAIT_L(0); PG8_BAR; PG8_MMA(0, 0, At, B0); PG8_MMA(0, 1, At, B1); PG8_BAR; PG8_SCHED;
            PG8_LDA(At, 0, 1); PG8_STAGE(PG8_SB(0, 0), b2, voffB); PG8_STAGE(PG8_SB(0, 1), b2 + hstep, voffB); PG8_STAGE(PG8_SA(0, 0), a2, voffA);
            PG8_WAIT_V(8); PG8_WAIT_L(0); PG8_BAR; PG8_MMA(1, 0, At, B0); PG8_MMA(1, 1, At, B1); PG8_BAR; PG8_SCHED;
            PG8_LDB(B0, 1, 0); PG8_LDB(B1, 1, 1); PG8_SCHED; PG8_LDA(At, 1, 0); PG8_STAGE(PG8_SA(0, 1), a2 + hstep, voffA);
            PG8_WAIT_V(8); PG8_WAIT_L(0); PG8_BAR; PG8_MMA(0, 0, At, B0); PG8_MMA(0, 1, At, B1); PG8_BAR; PG8_SCHED;
            PG8_LDA(At, 1, 1); PG8_STAGE(PG8_SB(1, 0), b3, voffB); PG8_STAGE(PG8_SB(1, 1), b3 + hstep, voffB); PG8_STAGE(PG8_SA(1, 0), a3, voffA);
            PG8_WAIT_V(8); PG8_WAIT_L(0); PG8_BAR; PG8_MMA(1, 0, At, B0); PG8_MMA(1, 1, At, B1); PG8_BAR; PG8_SCHED;
            } else {
            PG8_LDB(B0, 0, 0); PG8_SCHED; PG8_LDA(At, 0, 0); PG8_STAGE(PG8_SA(1, 1), a1 + hstep, voffA);
            PG8_WAIT_L(8); PG8_BAR; PG8_WAIT_L(0); PG8_MMA(0, 0, At, B0); PG8_BAR; PG8_SCHED;
            PG8_LDB(B1, 0, 1); PG8_STAGE(PG8_SB(0, 0), b2, voffB);
            PG8_BAR; PG8_WAIT_L(0); PG8_MMA(0, 1, At, B1); PG8_BAR;
            PG8_LDA(At, 0, 1); PG8_STAGE(PG8_SA(0, 0), a2, voffA);
            PG8_BAR; PG8_WAIT_L(0); PG8_MMA(1, 0, At, B0); PG8_BAR; PG8_SCHED;
            PG8_STAGE(PG8_SB(0, 1), b2 + hstep, voffB);
            PG8_WAIT_V(6); PG8_BAR; PG8_MMA(1, 1, At, B1); PG8_BAR;
            PG8_LDB(B0, 1, 0); PG8_SCHED; PG8_LDA(At, 1, 0); PG8_STAGE(PG8_SA(0, 1), a2 + hstep, voffA);
            PG8_WAIT_L(8); PG8_BAR; PG8_WAIT_L(0); PG8_MMA(0, 0, At, B0); PG8_BAR; PG8_SCHED;
            PG8_LDB(B1, 1, 1); PG8_STAGE(PG8_SB(1, 0), b3, voffB);
            PG8_BAR; PG8_WAIT_L(0); PG8_MMA(0, 1, At, B1); PG8_BAR;
            PG8_LDA(At, 1, 1); PG8_STAGE(PG8_SA(1, 0), a3, voffA);
            PG8_BAR; PG8_WAIT_L(0); PG8_MMA(1, 0, At, B0); PG8_BAR; PG8_SCHED;
            PG8_STAGE(PG8_SB(1, 1), b3 + hstep, voffB);
            PG8_WAIT_V(6); PG8_BAR; PG8_MMA(1, 1, At, B1); PG8_BAR;
            }
        }
        if constexpr (ALIGN_EPI) { if (wr == 0) PG8_BAR; }
        if constexpr (!Epi::AFTER_DRAIN) { E(acc, cur, wr, wc, fr, fq); S.done(cur); }
        if (!has_next) break;
#pragma unroll
        for (int a = 0; a < 2; ++a)
#pragma unroll
            for (int b = 0; b < 2; ++b)
#pragma unroll
                for (int m = 0; m < 4; ++m)
#pragma unroll
                    for (int n = 0; n < 2; ++n) acc[a][b][m][n] = (f32x4){0.f, 0.f, 0.f, 0.f};
        cur = nxt; cA = nA; cB = nB; ++ui;
        if constexpr (ALIGN_EPI) { if (wr == 1) PG8_BAR; }
    }
    PG8_WAIT_V(0);
    if constexpr (!ALIGN_EPI) { if (wr == 0) PG8_BAR; }
    PG8_BAR;
    if constexpr (Epi::AFTER_DRAIN) { E.fused(acc, cur, wr, wc, fr, fq, lds, wid, lane); S.done(cur); }
#undef PG8_SA
#undef PG8_SB
#undef PG8_STAGE
#undef PG8_LDA
#undef PG8_LDB
#undef PG8_MMA
#undef PG8_WAIT_V
#undef PG8_WAIT_L
#undef PG8_BAR
#undef PG8_SCHED
}
}

typedef pg8::Unit Unit;
typedef f32x4 Acc[2][2][4][2];

__device__ __forceinline__ void load_rs(const float* ssq, const Unit& u, int wr, int fr, int fq, float (&rs)[2][4]) {
#pragma unroll
    for (int ai = 0; ai < 2; ++ai)
#pragma unroll
        for (int m = 0; m < 4; ++m) { const int row = u.pm * 256 + ai * 128 + wr * 64 + m * 16 + fr;
            const f32x4 p = *(const f32x4*)(ssq + (size_t)row * 16 + 4 * fq); float s = (p.x + p.y) + (p.z + p.w);
            s += __shfl_xor(s, 16); s += __shfl_xor(s, 32); rs[ai][m] = rsqrtf(s * (1.0f / D) + EPS); }
}
template <int ACT, int SPLIT> struct EpiBf16S {
    static constexpr bool PERM = true, AFTER_DRAIN = false;
    const float* ssq; bf16* O; int ldc; bf16 *Q, *K, *V, *Gt;
    __device__ __forceinline__ void operator()(const Acc& acc, const Unit& u, int wr, int wc, int fr, int fq) const {
        float rs[2][4]; load_rs(ssq, u, wr, fr, fq, rs);
        bf16* base = O; int ld = ldc, colt = u.pn * 256;
        if (SPLIT) { if (u.pn < 2) { base = Q; ld = 512; } else if (u.pn < 4) { base = K; ld = 512; colt -= 512; } else if (u.pn < 8) { base = V; ld = 1024; colt -= 1024; } else { base = Gt; ld = 1024; colt -= 2048; } }
        const int row0 = u.pm * 256 + wr * 64 + fr, col0 = colt + wc * 32 + 8 * fq;
#pragma unroll
        for (int ai = 0; ai < 2; ++ai)
#pragma unroll
            for (int m = 0; m < 4; ++m) { bf16* rowp = base + (size_t)(row0 + ai * 128 + m * 16) * ld + col0; const float s = rs[ai][m];
#pragma unroll
                for (int bj = 0; bj < 2; ++bj) { f32x4 v0 = acc[ai][bj][m][0] * s, v1 = acc[ai][bj][m][1] * s;
                    if (ACT == 1) {
#pragma unroll
                        for (int e = 0; e < 4; ++e) { const float a = fmaxf(v0[e], 0.f), b = fmaxf(v1[e], 0.f); v0[e] = a * a; v1[e] = b * b; } }
                    u32x4 w; w.x = cvtpk(v0[0], v0[1]); w.y = cvtpk(v0[2], v0[3]); w.z = cvtpk(v1[0], v1[1]); w.w = cvtpk(v1[2], v1[3]);
                    *(u32x4*)(rowp + bj * 128) = w; } }
    }
};
struct EpiResid {
    static constexpr bool PERM = true, AFTER_DRAIN = false;
    const float* base; float* out; bf16* hb; float* ssq;
    __device__ __forceinline__ void operator()(const Acc& acc, const Unit& u, int wr, int wc, int fr, int fq) const {
        const int row0 = u.pm * 256 + wr * 64 + fr, col0 = u.pn * 256 + wc * 32 + 8 * fq;
#pragma unroll
        for (int ai = 0; ai < 2; ++ai)
#pragma unroll
            for (int m = 0; m < 4; ++m) { const int row = row0 + ai * 128 + m * 16; const size_t off = (size_t)row * D + col0; float ss = 0.f;
#pragma unroll
                for (int bj = 0; bj < 2; ++bj) { const f32x4 b0 = *(const f32x4*)(base + off + bj * 128), b1 = *(const f32x4*)(base + off + bj * 128 + 4);
                    const f32x4 v0 = acc[ai][bj][m][0] + b0, v1 = acc[ai][bj][m][1] + b1;
                    *(f32x4*)(out + off + bj * 128) = v0; *(f32x4*)(out + off + bj * 128 + 4) = v1;
                    u32x4 w; w.x = cvtpk(v0[0], v0[1]); w.y = cvtpk(v0[2], v0[3]); w.z = cvtpk(v1[0], v1[1]); w.w = cvtpk(v1[2], v1[3]);
                    *(u32x4*)(hb + off + bj * 128) = w;
                    ss += (v0[0] * v0[0] + v0[1] * v0[1]) + (v0[2] * v0[2] + v0[3] * v0[3]) + (v1[0] * v1[0] + v1[1] * v1[1]) + (v1[2] * v1[2] + v1[3] * v1[3]); }
                ss += __shfl_xor(ss, 16); ss += __shfl_xor(ss, 32);
                if (fq == 0) ssq[(size_t)row * 16 + u.pn * 4 + wc] = ss; }
    }
};

template <class Epi> __device__ __forceinline__ void gemm_slow(const Ctx& F, const bf16* A, const bf16* Bt, int Mr, int N, int K, const Epi& E) {
    const int wr = F.wave >> 2, wc = F.wave & 3, fr = F.lane & 15, fq = F.lane >> 4;
    const int nM = Mr / 256, nN = N / 256;
    for (int un = F.bid; un < nM * nN; un += F.G) {
        Unit u; u.pm = un / nN; u.pn = un % nN;
        Acc acc;
#pragma unroll
        for (int a = 0; a < 2; ++a)
#pragma unroll
            for (int b = 0; b < 2; ++b)
#pragma unroll
                for (int m = 0; m < 4; ++m)
#pragma unroll
                    for (int n = 0; n < 2; ++n) acc[a][b][m][n] = (f32x4){0.f, 0.f, 0.f, 0.f};
        const bf16* ap = A + (size_t)(u.pm * 256 + wr * 64 + fr) * K + 8 * fq;
        const bf16* bp0 = Bt + (size_t)(u.pn * 256 + wc * 32 + perm32(fr)) * K + 8 * fq;
        const bf16* bp1 = Bt + (size_t)(u.pn * 256 + wc * 32 + perm32(16 + fr)) * K + 8 * fq;
        for (int k0 = 0; k0 < K; k0 += 32) {
            bf16x8 a[2][4], b[2][2];
#pragma unroll
            for (int ai = 0; ai < 2; ++ai)
#pragma unroll
                for (int m = 0; m < 4; ++m) a[ai][m] = *(const bf16x8*)(ap + (size_t)(ai * 128 + m * 16) * K + k0);
#pragma unroll
            for (int bj = 0; bj < 2; ++bj) { b[bj][0] = *(const bf16x8*)(bp0 + (size_t)(bj * 128) * K + k0); b[bj][1] = *(const bf16x8*)(bp1 + (size_t)(bj * 128) * K + k0); }
#pragma unroll
            for (int ai = 0; ai < 2; ++ai)
#pragma unroll
                for (int bj = 0; bj < 2; ++bj)
#pragma unroll
                    for (int m = 0; m < 4; ++m)
#pragma unroll
                        for (int n = 0; n < 2; ++n) acc[ai][bj][m][n] = __builtin_amdgcn_mfma_f32_16x16x32_bf16(b[bj][n], a[ai][m], acc[ai][bj][m][n], 0, 0, 0);
        }
        E(acc, u, wr, wc, fr, fq);
    }
}


#ifndef USE_SLOW_GEMM
#define USE_SLOW_GEMM 0
#endif
template <class Epi> __device__ __forceinline__ void gemm_run(const Ctx& F, const bf16* A, const bf16* Bt, int Mr, int N, int K, const Epi& E) {
#if USE_SLOW_GEMM
    gemm_slow(F, A, Bt, Mr, N, K, E);
#else
    pg8::Gemm g{A, Bt, Mr, N, K}; pg8::StaticOrder S; S.init(Mr, N, F.G, F.bid);
    pg8::gemm_phase<Epi, pg8::StaticOrder, true, true>(F.lds, g, S, E);
#endif
}
__device__ __forceinline__ f32x4 skinny_task(const bf16* A, int lda, const bf16* Bt, int ldb, int K, int lane) {
    const int fr = lane & 15, fq = lane >> 4;
    const bf16* ap = A + (size_t)fr * lda + 8 * fq; const bf16* bp = Bt + (size_t)fr * ldb + 8 * fq;
    f32x4 acc = {0.f, 0.f, 0.f, 0.f};
#pragma unroll 8
    for (int k = 0; k < K; k += 32) { const bf16x8 a = *(const bf16x8*)(ap + k), b = *(const bf16x8*)(bp + k); acc = __builtin_amdgcn_mfma_f32_16x16x32_bf16(b, a, acc, 0, 0, 0); }
    return acc;
}
__device__ __forceinline__ float meta_rs(const float* ssqm, int lane) {
    const int fr = lane & 15, fq = lane >> 4; const f32x4* p = (const f32x4*)(ssqm + fr * 64 + 16 * fq); float s = 0.f;
#pragma unroll
    for (int j = 0; j < 4; ++j) { const f32x4 v = p[j]; s += (v.x + v.y) + (v.z + v.w); }
    s += __shfl_xor(s, 16); s += __shfl_xor(s, 32); return rsqrtf(s * (1.0f / D) + EPS);
}
__device__ __forceinline__ int meta_task_id(const Ctx& F) { return F.wave * F.G + F.bid; }
template <int ACT> __device__ __forceinline__ void meta_scale_gemm(const Ctx& F, const bf16* Wt, int N, int K, bf16* O) {
    const bf16* hbm = F.wsb(WS_META + MT_HBM); const float* ssqm = F.wsf(WS_META + MT_SSQM);
    for (int t = meta_task_id(F); t < N / 16; t += F.G * NWAVES) {
        const float rs = meta_rs(ssqm, F.lane); f32x4 acc = skinny_task(hbm, D, Wt + (size_t)t * 16 * K, K, K, F.lane) * rs;
        if (ACT == 1) {
#pragma unroll
            for (int e = 0; e < 4; ++e) { const float a = fmaxf(acc[e], 0.f); acc[e] = a * a; } }
        u32x2 o; o.x = cvtpk(acc[0], acc[1]); o.y = cvtpk(acc[2], acc[3]);
        *(u32x2*)(O + (size_t)(F.lane & 15) * N + t * 16 + 4 * (F.lane >> 4)) = o;
    }
}
__device__ __forceinline__ void meta_resid_gemm(const Ctx& F, const bf16* A16, int K, const bf16* Wt, const float* base) {
    float* hm = F.wsf(WS_META + MT_HM); bf16* hbm = F.wsb(WS_META + MT_HBM); float* ssqm = F.wsf(WS_META + MT_SSQM);
    for (int t = meta_task_id(F); t < D / 16; t += F.G * NWAVES) {
        const int fr = F.lane & 15, fq = F.lane >> 4; const size_t off = (size_t)fr * D + t * 16 + 4 * fq;
        f32x4 acc = skinny_task(A16, K, Wt + (size_t)t * 16 * K, K, K, F.lane);
        const f32x4 v = acc + *(const f32x4*)(base + off);
        *(f32x4*)(hm + off) = v; u32x2 o; o.x = cvtpk(v[0], v[1]); o.y = cvtpk(v[2], v[3]);
        float ss = (v[0] * v[0] + v[1] * v[1]) + (v[2] * v[2] + v[3] * v[3]); ss += __shfl_xor(ss, 16); ss += __shfl_xor(ss, 32);
        *(u32x2*)(hbm + off) = o; if (fq == 0) ssqm[fr * 64 + t] = ss;
    }
}

template <int W> __device__ __forceinline__ void pool_block(const Ctx& F, float (&pw)[47], int t0s, int c, bf16* mixrow0, bool meta_unit) {
#pragma unroll
    for (int i = 0; i < 32; ++i) {
        float s = 0.f;
#pragma unroll
        for (int j = 0; j < W; ++j) s += pw[15 + i - j];
        const int tg = t0s + i + NMETA; const int cnt = tg + 1 < W ? tg + 1 : W;
        const float v = s * (1.0f / (float)cnt) - pw[15 + i];
        const bool st = meta_unit ? (i < 16) : true;
        if (st) mixrow0[(size_t)i * D + 512 + c] = f2bf(v);
    }
}
__device__ __forceinline__ void phase_convpool(const Ctx& F) {
    const int c = F.tid;
    const float* cw = F.in[7]; float w[31];
#pragma unroll
    for (int j = 0; j < 31; ++j) w[j] = cw[j * 512 + c];
    const float cb = F.in[8][c];
    const float* lng = F.in[9]; const float* lnb = F.in[10];
    const bf16* Z0 = F.wsb(WS_Z0); const bf16* ZM = F.wsb(WS_META + MT_ZM);
    bf16* MIX0 = F.wsb(WS_MIX0); bf16* MIXM = F.wsb(WS_META + MT_MIXM);
    LAS float* Y = (LAS float*)F.lds;
    const int g = c >> 7;
    for (int un = F.bid; un < 257; un += F.G) {
        const bool meta_unit = un == 256; const int b = meta_unit ? 0 : un >> 6; const int t0 = meta_unit ? -16 : (un & 63) * 64;
        float win[62], pw[47];
        for (int sb = 0; sb < (meta_unit ? 1 : 2); ++sb) {
            const int t0s = t0 + 32 * sb;
#pragma unroll
            for (int j = 0; j < 62; ++j) {
                if (sb == 1 && j < 30) { win[j] = win[j + 32]; continue; }
                const int t = t0s - 30 + j; float v = 0.f;
                if (t >= -NMETA) { const bf16* zr = t >= 0 ? Z0 + ((size_t)b * SEQ + t) * ZN0 : ZM + (size_t)(t + NMETA) * ZN0; v = bf2f(zr[c]) * sigmoidf_(bf2f(zr[512 + c])); }
                win[j] = v;
            }
#pragma unroll
            for (int j = 0; j < 47; ++j) {
                if (sb == 1 && j < 15) { pw[j] = pw[j + 32]; continue; }
                const int t = t0s - 15 + j; float v = 0.f;
                if (t >= -NMETA) { const bf16* zr = t >= 0 ? Z0 + ((size_t)b * SEQ + t) * ZN0 : ZM + (size_t)(t + NMETA) * ZN0; v = bf2f(zr[1024 + c]); }
                pw[j] = v;
            }
#pragma unroll
            for (int i = 0; i < 32; ++i) { float y = cb;
#pragma unroll
                for (int j = 0; j < 31; ++j) y = fmaf(w[j], win[i + j], y);
                Y[i * 512 + c] = y; }
            __syncthreads();
#pragma unroll
            for (int rr = 0; rr < 4; ++rr) {
                const int i = F.wave * 4 + rr; const int t = t0s + i;
                const f32x4 y0 = *(const LAS f32x4*)(Y + i * 512 + 8 * F.lane), y1 = *(const LAS f32x4*)(Y + i * 512 + 8 * F.lane + 4);
                const float mean = wave_sum((y0.x + y0.y) + (y0.z + y0.w) + (y1.x + y1.y) + (y1.z + y1.w)) * (1.0f / 512.0f);
                const f32x4 d0 = y0 - mean, d1 = y1 - mean;
                const float var = wave_sum((d0.x * d0.x + d0.y * d0.y) + (d0.z * d0.z + d0.w * d0.w) + (d1.x * d1.x + d1.y * d1.y) + (d1.z * d1.z + d1.w * d1.w)) * (1.0f / 512.0f);
                const float rstd = rsqrtf(var + EPS);
                const f32x4 g0 = *(const f32x4*)(lng + 8 * F.lane), g1 = *(const f32x4*)(lng + 8 * F.lane + 4), b0 = *(const f32x4*)(lnb + 8 * F.lane), b1 = *(const f32x4*)(lnb + 8 * F.lane + 4);
                f32x4 o0, o1;
#pragma unroll
                for (int e = 0; e < 4; ++e) { o0[e] = siluf_(d0[e] * rstd * g0[e] + b0[e]); o1[e] = siluf_(d1[e] * rstd * g1[e] + b1[e]); }
                u32x4 wv; wv.x = cvtpk(o0[0], o0[1]); wv.y = cvtpk(o0[2], o0[3]); wv.z = cvtpk(o1[0], o1[1]); wv.w = cvtpk(o1[2], o1[3]);
                const bool st = meta_unit ? (t < 0) : true;
                bf16* orow = t >= 0 ? MIX0 + ((size_t)b * SEQ + t) * D : MIXM + (size_t)(t + NMETA) * D;
                if (st) *(u32x4*)(orow + 8 * F.lane) = wv;
            }
            {
                bf16* mixrow0 = t0s >= 0 ? MIX0 + ((size_t)b * SEQ + t0s) * D : MIXM + (size_t)(t0s + NMETA) * D;
                if (g == 0) pool_block<2>(F, pw, t0s, c, mixrow0, meta_unit);
                else if (g == 1) pool_block<4>(F, pw, t0s, c, mixrow0, meta_unit);
                else if (g == 2) pool_block<8>(F, pw, t0s, c, mixrow0, meta_unit);
                else pool_block<16>(F, pw, t0s, c, mixrow0, meta_unit);
            }
            __syncthreads();
        }
    }
}

__device__ __forceinline__ float logsig_fast(float x) { return fminf(x, 0.f) - 0.6931471805599453f * __log2f(1.0f + __expf(-fabsf(x))); }
__device__ __forceinline__ void phase_prep(const Ctx& F) {
    const int p = F.tid & 255, hh = F.tid >> 8;
    const float* w2p = F.in[15]; f32x2 w2[16];
#pragma unroll
    for (int j = 0; j < 16; ++j) w2[j] = *(const f32x2*)(w2p + j * 512 + 2 * p);
    const f32x2 gb = *(const f32x2*)(F.in[16] + 2 * p);
    LAS float* rl = (LAS float*)F.lds;
    LAS float* th = (LAS float*)(F.lds + 4096);
    LAS float* lat = (LAS float*)(F.lds + 8192);
    for (int un = F.bid; un < 257; un += F.G) {
        const bool meta_unit = un == 256; const int nv = meta_unit ? 16 : 64;
        const size_t row0 = meta_unit ? 0 : (size_t)un * 64;
        const float* Rp = meta_unit ? F.wsf(WS_META + MT_RM) : F.wsf(WS_R) + row0 * 16;
        bf16* Kp = (meta_unit ? F.wsb(WS_META + MT_KM) : F.wsb(WS_K) + row0 * 512) + 2 * p;
        __syncthreads();
        for (int i = F.tid; i < nv * 16; i += NTHREADS) rl[i] = Rp[i];
        __syncthreads();
        float ra = 0.f, rb = 0.f;
#pragma unroll 2
        for (int cc = 0; cc < 32; ++cc) { const int c = 32 * hh + cc; f32x2 la = {0.f, 0.f};
            if (c < nv) { float pa = gb.x, pb = gb.y;
#pragma unroll
                for (int j4 = 0; j4 < 4; ++j4) { const f32x4 r4 = *(const LAS f32x4*)(rl + c * 16 + 4 * j4);
#pragma unroll
                    for (int e = 0; e < 4; ++e) { pa = fmaf(r4[e], w2[4 * j4 + e].x, pa); pb = fmaf(r4[e], w2[4 * j4 + e].y, pb); } }
                la.x = logsig_fast(pa) * (1.0f / 16.0f); la.y = logsig_fast(pb) * (1.0f / 16.0f); }
            ra += la.x; rb += la.y; *(LAS f32x2*)(lat + c * 512 + 2 * p) = la; }
        th[hh * 512 + 2 * p] = ra; th[hh * 512 + 2 * p + 1] = rb;
        __syncthreads();
        const float t0a = th[2 * p], t0b = th[2 * p + 1], t1a = th[512 + 2 * p], t1b = th[512 + 2 * p + 1];
        const float tota = t0a + t1a, totb = t0b + t1b;
        float resta = hh ? t1a : tota, restb = hh ? t1b : totb;
        if (!meta_unit && hh == 0) *(f32x2*)(F.wsf(WS_DTOT) + (size_t)un * 512 + 2 * p) = (f32x2){__expf(tota), __expf(totb)};
#pragma unroll 8
        for (int cc = 0; cc < 32; ++cc) { const int c = 32 * hh + cc;
            if (c < nv) { const unsigned kr = *(const unsigned*)(Kp + (size_t)c * 512); const f32x2 la = *(const LAS f32x2*)(lat + c * 512 + 2 * p);
                resta -= la.x; restb -= la.y;
                *(unsigned*)(Kp + (size_t)c * 512) = cvtpk(__uint_as_float(kr << 16) * __expf(resta), __uint_as_float(kr & 0xffff0000u) * __expf(restb)); } }
    }
}

typedef short v4i16_t __attribute__((ext_vector_type(4)));
__device__ __forceinline__ bf16x4 lds_tr16(const LAS unsigned char* p) { return __builtin_bit_cast(bf16x4, __builtin_amdgcn_ds_read_tr16_b64_v4i16((LAS v4i16_t*)p)); }
__device__ __forceinline__ unsigned swz_b(unsigned row) { return ((row & 3u) << 2) | ((row >> 2) & 3u); }
__device__ __forceinline__ unsigned off_b(unsigned row, unsigned ch) { return 256u * row + 16u * (ch ^ swz_b(row)); }
constexpr int SC_KD = 0, SC_Q = 32768, SC_V = 65536, SC_PART = 69632, SC_PSTR = 68;
static_assert(SC_PART + 2 * 8 * 16 * SC_PSTR * 4 <= 146944, "scan LDS map");
struct ScanRegs { u32x4 kd[2], q[2], v; f32x4 d; };
__device__ __forceinline__ void phase_scan(const Ctx& F) {
    const int fr = F.lane & 15, fq = F.lane >> 4, w = F.wave, tid = F.tid;
    LAS unsigned char* lds = F.lds;
    LAS float* part = (LAS float*)(lds + SC_PART);
    const unsigned q_ = (unsigned)(F.lane & 15) >> 2, p_ = (unsigned)F.lane & 3u;
    unsigned tra[2][2], trv[2][2];
#pragma unroll
    for (int ks = 0; ks < 2; ++ks)
#pragma unroll
        for (int t = 0; t < 2; ++t) { const unsigned row = 32u * ks + 8u * fq + 4u * t + q_; tra[ks][t] = off_b(row, 2u * w + (p_ >> 1)) + 8u * (p_ & 1u); trv[ks][t] = row * 32u + 8u * p_; }
    const unsigned qch_ = 2u * w + ((unsigned)fq >> 1), qlo_ = 8u * ((unsigned)fq & 1u);
    const unsigned qoff0 = off_b(fr, qch_) + qlo_, qoff1 = off_b(16u + fr, qch_) + qlo_, qoff2 = off_b(32u + fr, qch_) + qlo_, qoff3 = off_b(48u + fr, qch_) + qlo_;
    unsigned grow[2], gch[2];
#pragma unroll
    for (int i = 0; i < 2; ++i) { const unsigned id = tid + 512u * i, row = id >> 4, chp = id & 15u; grow[i] = row; gch[i] = chp ^ swz_b(row); }
    const bool vth = tid < 128; const unsigned vrow = ((unsigned)tid & 127u) >> 1, vch = (unsigned)tid & 1u;
    for (int un = F.bid; un < 256; un += F.G) {
        const int xcd = un & 7, idx = un >> 3, pair = xcd * 2 + (idx >> 4), vs = idx & 15, b = pair >> 2, h = pair & 3;
        const bf16* Kb = F.wsb(WS_K) + (size_t)b * SEQ * 512 + h * 128;
        const bf16* Qb = F.wsb(WS_Q) + (size_t)b * SEQ * 512 + h * 128;
        const bf16* Vb = F.wsb(WS_V) + (size_t)b * SEQ * D + h * 256 + vs * 16;
        const float* DT = F.wsf(WS_DTOT) + (size_t)b * NCH * 512 + h * 128 + 16 * w + 4 * fq;
        bf16* Ob = F.wsb(WS_O) + (size_t)b * SEQ * D + h * 256 + vs * 16;
        f32x4 S = {0.f, 0.f, 0.f, 0.f};
        ScanRegs R0, R1, R2, R3;
#define SC_LOAD(R, n) do { const size_t t0_ = (size_t)(n) * 64; \
            _Pragma("unroll") for (int i = 0; i < 2; ++i) { (R).kd[i] = *(const u32x4*)(Kb + (t0_ + grow[i]) * 512 + gch[i] * 8); (R).q[i] = *(const u32x4*)(Qb + (t0_ + grow[i]) * 512 + gch[i] * 8); } \
            (R).v = *(const u32x4*)(Vb + (t0_ + vrow) * D + vch * 8); \
            (R).d = *(const f32x4*)(DT + (size_t)(n) * 512); } while (0)
#define SC_WRITE(R, buf) do { \
            _Pragma("unroll") for (int i = 0; i < 2; ++i) { *(LAS u32x4*)(lds + SC_KD + (buf) * 16384 + 16 * (tid + 512 * i)) = (R).kd[i]; *(LAS u32x4*)(lds + SC_Q + (buf) * 16384 + 16 * (tid + 512 * i)) = (R).q[i]; } \
            if (vth) *(LAS u32x4*)(lds + SC_V + (buf) * 2048 + 16 * tid) = (R).v; } while (0)
#define SC_UPDATE(buf) do { \
            const LAS unsigned char* kt_ = lds + SC_KD + (buf) * 16384; const LAS unsigned char* vt_ = lds + SC_V + (buf) * 2048; \
            const bf16x4 a00 = lds_tr16(kt_ + tra[0][0]), a01 = lds_tr16(kt_ + tra[0][1]), a10 = lds_tr16(kt_ + tra[1][0]), a11 = lds_tr16(kt_ + tra[1][1]); \
            const bf16x4 b00 = lds_tr16(vt_ + trv[0][0]), b01 = lds_tr16(vt_ + trv[0][1]), b10 = lds_tr16(vt_ + trv[1][0]), b11 = lds_tr16(vt_ + trv[1][1]); \
            const bf16x8 a0 = __builtin_shufflevector(a00, a01, 0, 1, 2, 3, 4, 5, 6, 7), a1 = __builtin_shufflevector(a10, a11, 0, 1, 2, 3, 4, 5, 6, 7); \
            const bf16x8 b0 = __builtin_shufflevector(b00, b01, 0, 1, 2, 3, 4, 5, 6, 7), b1 = __builtin_shufflevector(b10, b11, 0, 1, 2, 3, 4, 5, 6, 7); \
            S = __builtin_amdgcn_mfma_f32_16x16x32_bf16(a0, b0, S, 0, 0, 0); S = __builtin_amdgcn_mfma_f32_16x16x32_bf16(a1, b1, S, 0, 0, 0); } while (0)
        SC_LOAD(R0, 0); SC_LOAD(R1, 1); SC_LOAD(R2, 2); SC_LOAD(R3, 3);
        {
            const bf16* KM = F.wsb(WS_META + MT_KM) + h * 128; const bf16* VM = F.wsb(WS_META + MT_VM) + h * 256 + vs * 16;
#pragma unroll
            for (int i = 0; i < 2; ++i) { u32x4 z = {0u, 0u, 0u, 0u}; if (grow[i] < 16u) z = *(const u32x4*)(KM + (size_t)grow[i] * 512 + gch[i] * 8); *(LAS u32x4*)(lds + SC_KD + 16384 + 16 * (tid + 512 * i)) = z; }
            if (vth) { u32x4 z = {0u, 0u, 0u, 0u}; if (vrow < 16u) z = *(const u32x4*)(VM + (size_t)vrow * D + vch * 8); *(LAS u32x4*)(lds + SC_V + 2048 + 16 * tid) = z; }
            __syncthreads();
            SC_UPDATE(1);
        }
        SC_WRITE(R0, 0);
        __syncthreads();
#define SC_STEP(R, RN, n) do { const int n_ = (n); const int buf_ = n_ & 1; \
            const LAS unsigned char* qt_ = lds + SC_Q + buf_ * 16384; \
            const bf16x4 qa0_ = *(const LAS bf16x4*)(qt_ + qoff0), qa1_ = *(const LAS bf16x4*)(qt_ + qoff1), qa2_ = *(const LAS bf16x4*)(qt_ + qoff2), qa3_ = *(const LAS bf16x4*)(qt_ + qoff3); \
            S = S * (R).d; SC_UPDATE(buf_); \
            { u32x2 sb2; sb2.x = cvtpk(S[0], S[1]); sb2.y = cvtpk(S[2], S[3]); const bf16x4 sb = __builtin_bit_cast(bf16x4, sb2); \
              LAS float* pw = part + ((size_t)(buf_ * 8 + w) * 16 + fr) * SC_PSTR + 4 * fq; \
              const f32x4 z4_ = {0.f, 0.f, 0.f, 0.f}; \
              const f32x4 o0_ = __builtin_amdgcn_mfma_f32_16x16x16bf16_1k(qa0_, sb, z4_, 0, 0, 0), o1_ = __builtin_amdgcn_mfma_f32_16x16x16bf16_1k(qa1_, sb, z4_, 0, 0, 0); \
              const f32x4 o2_ = __builtin_amdgcn_mfma_f32_16x16x16bf16_1k(qa2_, sb, z4_, 0, 0, 0), o3_ = __builtin_amdgcn_mfma_f32_16x16x16bf16_1k(qa3_, sb, z4_, 0, 0, 0); \
              *(LAS f32x4*)(pw) = o0_; *(LAS f32x4*)(pw + 16) = o1_; *(LAS f32x4*)(pw + 32) = o2_; *(LAS f32x4*)(pw + 48) = o3_; } \
            SC_WRITE(RN, buf_ ^ 1); \
            SC_LOAD(R, (n_ + 4 < NCH ? n_ + 4 : NCH - 1)); \
            __syncthreads(); \
            { const int c = tid >> 3, v2 = (tid & 7) * 2; float s0 = 0.f, s1 = 0.f; \
              _Pragma("unroll") for (int ww = 0; ww < 8; ++ww) { const LAS float* pr = part + ((size_t)(buf_ * 8 + ww) * 16 + v2) * SC_PSTR + c; s0 += pr[0]; s1 += pr[SC_PSTR]; } \
              *(unsigned*)(Ob + (size_t)(n_ * 64 + c) * D + v2) = cvtpk(s0, s1); } } while (0)
        for (int n0 = 0; n0 < NCH; n0 += 4) { SC_STEP(R0, R1, n0); SC_STEP(R1, R2, n0 + 1); SC_STEP(R2, R3, n0 + 2); SC_STEP(R3, R0, n0 + 3); }
        __syncthreads();
#undef SC_LOAD
#undef SC_WRITE
#undef SC_UPDATE
#undef SC_STEP
    }
}

__device__ __forceinline__ void phase_gate(const Ctx& F, bf16* Oout) {
    const float* hg = F.in[17]; const f32x4 g4 = *(const f32x4*)(hg + 4 * F.lane);
    bf16* O = F.wsb(WS_O); const bf16* Gt = F.wsb(WS_G);
    const int gw = F.bid * NWAVES + F.wave, NGW = F.G * NWAVES;
    for (int it = gw; it < M * 4; it += NGW) {
        const size_t off = (size_t)it * 256 + 4 * F.lane;
        const u32x2 ov = *(const u32x2*)(O + off), gv = *(const u32x2*)(Gt + off);
        const float o0 = __uint_as_float(ov.x << 16), o1 = __uint_as_float(ov.x & 0xffff0000u), o2 = __uint_as_float(ov.y << 16), o3 = __uint_as_float(ov.y & 0xffff0000u);
        const float x0 = __uint_as_float(gv.x << 16), x1 = __uint_as_float(gv.x & 0xffff0000u), x2 = __uint_as_float(gv.y << 16), x3 = __uint_as_float(gv.y & 0xffff0000u);
        const float rs = rsqrtf(wave_sum((o0 * o0 + o1 * o1) + (o2 * o2 + o3 * o3)) * (1.0f / 256.0f) + EPS);
        u32x2 r; r.x = cvtpk(o0 * rs * g4.x * siluf_(x0), o1 * rs * g4.y * siluf_(x1)); r.y = cvtpk(o2 * rs * g4.z * siluf_(x2), o3 * rs * g4.w * siluf_(x3));
        *(u32x2*)(Oout + off) = r;
    }
}
__device__ __forceinline__ void phase_final(const Ctx& F, float* dst) {
    const float* fg = F.in[19]; const float* ssq = F.wsf(WS_SSQ);
    const int gw = F.bid * NWAVES + F.wave, NGW = F.G * NWAVES;
    for (int m = gw; m < M; m += NGW) {
        float s = F.lane < 16 ? ssq[(size_t)m * 16 + F.lane] : 0.f; s = wave_sum(s);
        const float rs = rsqrtf(s * (1.0f / D) + EPS);
        const f32x4* xr = (const f32x4*)(F.out + (size_t)m * D) + F.lane; f32x4* dr = (f32x4*)(dst + (size_t)m * D) + F.lane;
#pragma unroll
        for (int j = 0; j < 4; ++j) { const f32x4 g = *((const f32x4*)fg + F.lane + 64 * j); f32x4 v = xr[64 * j]; v = v * rs * g; dr[64 * j] = v; }
    }
}
__device__ __forceinline__ void phase_r(const Ctx& F) {
    const bf16* Wr = F.wsb(WS_W_IN1) + (size_t)GN * D; const bf16* hb = F.wsb(WS_HB); const float* ssq = F.wsf(WS_SSQ); float* R = F.wsf(WS_R);
    const int gw = F.bid * NWAVES + F.wave, NGW = F.G * NWAVES;
    for (int t = gw; t < M / 16; t += NGW) {
        const int fr = F.lane & 15, fq = F.lane >> 4; const int row = t * 16 + fr;
        const f32x4 p = *(const f32x4*)(ssq + (size_t)row * 16 + 4 * fq); float s = (p.x + p.y) + (p.z + p.w); s += __shfl_xor(s, 16); s += __shfl_xor(s, 32);
        const float rs = rsqrtf(s * (1.0f / D) + EPS);
        const f32x4 acc = skinny_task(hb + (size_t)t * 16 * D, D, Wr, D, D, F.lane) * rs;
        *(f32x4*)(R + (size_t)row * 16 + 4 * fq) = acc;
    }
}
__device__ __forceinline__ void meta_in1(const Ctx& F) {
    const bf16* hbm = F.wsb(WS_META + MT_HBM); const float* ssqm = F.wsf(WS_META + MT_SSQM); const bf16* Wt = F.wsb(WS_W_IN1);
    for (int t = meta_task_id(F); t < (GNR - 512) / 16; t += F.G * NWAVES) {
        const int n0 = 512 + t * 16; if (n0 >= 2048 && n0 < GN) continue;
        const int fr = F.lane & 15, fq = F.lane >> 4;
        const float rs = meta_rs(ssqm, F.lane); const f32x4 acc = skinny_task(hbm, D, Wt + (size_t)n0 * D, D, D, F.lane) * rs;
        u32x2 o; o.x = cvtpk(acc[0], acc[1]); o.y = cvtpk(acc[2], acc[3]);
        if (n0 < 1024) *(u32x2*)(F.wsb(WS_META + MT_KM) + (size_t)fr * 512 + (n0 - 512) + 4 * fq) = o;
        else if (n0 < 2048) *(u32x2*)(F.wsb(WS_META + MT_VM) + (size_t)fr * 1024 + (n0 - 1024) + 4 * fq) = o;
        else *(f32x4*)(F.wsf(WS_META + MT_RM) + fr * 16 + 4 * fq) = acc;
    }
}


constexpr int CW_BAR = 4096;
constexpr int LDSCTL_OFF = LDS_BYTES - 512, MISC_OFF = LDSCTL_OFF + 320;
#define XB_TMO      128
#define XB_XCNT(j)  (256  + 64 * (j))
#define XB_XSUB(j)  (1280 + 64 * (j))
#define XB_XGEN(j)  (2304 + 64 * (j))
#define XB_TOP      3328
#define XB_TOPGEN   3392
#define XCD_BAR_WORDS 3456
#define XB_SPIN_CAP (1u << 18)
__device__ __forceinline__ unsigned xb_ld(unsigned* p)              { return __hip_atomic_load(p, __ATOMIC_RELAXED, __HIP_MEMORY_SCOPE_AGENT); }
__device__ __forceinline__ unsigned xb_add(unsigned* p, unsigned v) { return __hip_atomic_fetch_add(p, v, __ATOMIC_RELAXED, __HIP_MEMORY_SCOPE_AGENT); }
__device__ __forceinline__ unsigned xb_xcc_id() { return (unsigned)__builtin_amdgcn_s_getreg((3 << 11) | 20) & 0xFu; }
#define XB_SPIN(cond, bar) do { unsigned _sp = 0; while (cond) { __builtin_amdgcn_s_sleep(1); \
    if ((++_sp & 255u) == 0u) { if (xb_ld(&(bar)[XB_TMO])) break; if (_sp > XB_SPIN_CAP) { atomicAdd(&(bar)[XB_TMO], 1u); break; } } } } while (0)
struct XcdBarrier { unsigned* bar; unsigned x; volatile LAS unsigned* st; };
__device__ __forceinline__ XcdBarrier xcd_barrier_post(unsigned* bar, volatile LAS unsigned* st) {
    XcdBarrier b; b.bar = bar; b.x = xb_xcc_id(); b.st = st;
    if (threadIdx.x == 0) (void)xb_add(&bar[XB_XCNT(b.x)], 1u);
    return b;
}
__device__ __forceinline__ void xcd_barrier_complete(unsigned* bar, unsigned x, unsigned& nloc, unsigned& nx) {
    const unsigned G = gridDim.x * gridDim.y * gridDim.z;
    unsigned sum, cnt, mine, sp = 0u;
    for (;;) {
        sum = 0u; cnt = 0u; mine = 0u;
#pragma unroll
        for (unsigned j = 0; j < 16; ++j) { const unsigned c = xb_ld(&bar[XB_XCNT(j)]); sum += c; cnt += (c > 0u) ? 1u : 0u; mine = (j == x) ? c : mine; }
        if (sum == G) break;
        __builtin_amdgcn_s_sleep(1);
        if ((++sp & 255u) == 0u) { if (xb_ld(&bar[XB_TMO])) break; if (sp > XB_SPIN_CAP) { atomicAdd(&bar[XB_TMO], 1u); break; } }
    }
    nloc = mine > 0u ? mine : 1u; nx = cnt > 0u ? cnt : 1u;
}
__device__ __forceinline__ void xcd_barrier(const XcdBarrier& b) {
    asm volatile("s_waitcnt vmcnt(0)" ::: "memory");
    __syncthreads();
    if (threadIdx.x == 0) {
        unsigned* bar = b.bar;
        __builtin_amdgcn_s_waitcnt(0);
        unsigned nloc = b.st[0], nx = b.st[1];
        if (nloc == 0u) { xcd_barrier_complete(bar, b.x, nloc, nx); b.st[0] = nloc; b.st[1] = nx; }
        const unsigned old = xb_add(&bar[XB_XSUB(b.x)], 1u);
        const unsigned gen = old / nloc;
        if (old + 1u == (gen + 1u) * nloc) {
            __builtin_amdgcn_fence(__ATOMIC_RELEASE, "agent");
            asm volatile("s_waitcnt vmcnt(0)" ::: "memory");
            const unsigned og = xb_add(&bar[XB_TOP], 1u);
            const unsigned tg = og / nx;
            if (og + 1u == (tg + 1u) * nx) xb_add(&bar[XB_TOPGEN], 1u);
            else XB_SPIN(xb_ld(&bar[XB_TOPGEN]) == tg, bar);
            __builtin_amdgcn_fence(__ATOMIC_ACQUIRE, "agent");
            xb_add(&bar[XB_XGEN(b.x)], 1u);
            asm volatile("s_waitcnt vmcnt(0)" ::: "memory");
        } else {
            XB_SPIN(xb_ld(&bar[XB_XGEN(b.x)]) == gen, bar);
            __builtin_amdgcn_fence(__ATOMIC_ACQUIRE, "agent");
            asm volatile("s_waitcnt vmcnt(0)" ::: "memory");
        }
    }
    __syncthreads();
}

constexpr int N_PHASES = 14;
__global__ void __launch_bounds__(NTHREADS, 2) fwd_kernel(Args args) {
    extern __shared__ __attribute__((aligned(16))) unsigned char lds_raw[];
    Ctx F;
#pragma unroll
    for (int i = 0; i < 20; ++i) F.in[i] = args.in[i];
    F.out = args.out; F.ws = args.ws; F.lds = (LAS unsigned char*)lds_raw;
    F.tid = threadIdx.x; F.lane = F.tid & 63; F.wave = __builtin_amdgcn_readfirstlane(F.tid >> 6); F.G = gridDim.x; F.bid = blockIdx.x;
    const int lo = args.ph_lo, hi = args.ph_hi;
    for (int u = F.tid; u < (LDS_BYTES - LDSCTL_OFF) / 4; u += NTHREADS) ((LAS unsigned*)(F.lds + LDSCTL_OFF))[u] = 0u;
    __syncthreads();
    XcdBarrier bar = xcd_barrier_post((unsigned*)(F.ws + WS_CTL) + CW_BAR, (volatile LAS unsigned*)(F.lds + MISC_OFF) + 8);
#define IN(k) (lo <= (k) && (k) < hi)
#define REP(k) for (int r_ = 0, n_ = (args.probe_phase == (k) ? args.probe_reps : 1); r_ < n_; ++r_)
#define SEAM(k) do { if (IN(k) && IN((k) + 1)) xcd_barrier(bar); } while (0)
    if (IN(0)) phase_prologue(F);
    SEAM(0);
    if (IN(1)) {
        meta_scale_gemm<0>(F, F.wsb(WS_W_IN0), ZN0, D, F.wsb(WS_META + MT_ZM));
        EpiBf16S<0, 0> E{F.wsf(WS_SSQ), F.wsb(WS_Z0), ZN0, nullptr, nullptr, nullptr, nullptr};
        gemm_run(F, F.wsb(WS_HB), F.wsb(WS_W_IN0), M, ZN0, D, E);
    }
    SEAM(1);
    if (IN(2)) phase_convpool(F);
    SEAM(2);
    if (IN(3)) {
        meta_resid_gemm(F, F.wsb(WS_META + MT_MIXM), D, F.wsb(WS_W_OUT0), F.in[1]);
        EpiResid E{F.in[0], F.out, F.wsb(WS_HB), F.wsf(WS_SSQ)};
        gemm_run(F, F.wsb(WS_MIX0), F.wsb(WS_W_OUT0), M, D, D, E);
    }
    SEAM(3);
    if (IN(4)) {
        meta_scale_gemm<1>(F, F.wsb(WS_W1_0), FF, D, F.wsb(WS_META + MT_AM));
        EpiBf16S<1, 0> E{F.wsf(WS_SSQ), F.wsb(WS_A), FF, nullptr, nullptr, nullptr, nullptr};
        gemm_run(F, F.wsb(WS_HB), F.wsb(WS_W1_0), M, FF, D, E);
    }
    SEAM(4);
    if (IN(5)) {
        meta_resid_gemm(F, F.wsb(WS_META + MT_AM), FF, F.wsb(WS_W2_0), F.wsf(WS_META + MT_HM));
        EpiResid E{F.out, F.out, F.wsb(WS_HB), F.wsf(WS_SSQ)};
        gemm_run(F, F.wsb(WS_A), F.wsb(WS_W2_0), M, D, FF, E);
    }
    SEAM(5);
    if (IN(6)) {
        meta_in1(F);
        phase_r(F);
        EpiBf16S<0, 1> E{F.wsf(WS_SSQ), nullptr, 0, F.wsb(WS_Q), F.wsb(WS_K), F.wsb(WS_V), F.wsb(WS_G)};
        gemm_run(F, F.wsb(WS_HB), F.wsb(WS_W_IN1), M, GN, D, E);
    }
    SEAM(6);
    if (IN(7)) phase_prep(F);
    SEAM(7);
    if (IN(8)) phase_scan(F);
    SEAM(8);
    if (IN(9)) phase_gate(F, F.wsb(WS_O));
    SEAM(9);
    if (IN(10)) {
        EpiResid E{F.out, F.out, F.wsb(WS_HB), F.wsf(WS_SSQ)};
        gemm_run(F, F.wsb(WS_O), F.wsb(WS_W_OUT1), M, D, D, E);
    }
    SEAM(10);
    if (IN(11)) {
        EpiBf16S<1, 0> E{F.wsf(WS_SSQ), F.wsb(WS_A), FF, nullptr, nullptr, nullptr, nullptr};
        gemm_run(F, F.wsb(WS_HB), F.wsb(WS_W1_1), M, FF, D, E);
    }
    SEAM(11);
    if (IN(12)) {
        EpiResid E{F.out, F.out, F.wsb(WS_HB), F.wsf(WS_SSQ)};
        gemm_run(F, F.wsb(WS_A), F.wsb(WS_W2_1), M, D, FF, E);
    }
    SEAM(12);
    if (IN(13)) phase_final(F, F.out);
#undef IN
#undef SEAM
}

extern "C" void kernel_launch(void* const* d_in, const int* in_sizes, int n_in, void* d_out, int out_size, void* d_ws, size_t ws_size, hipStream_t stream) {
    static int grid = 0;
    if (grid == 0) {
        if (n_in != 20 || in_sizes[0] != M * D || out_size != M * D || ws_size < WS_END) { fprintf(stderr, "kernel_launch: unexpected shapes (n_in %d, in0 %d, out %d, ws %zu)\n", n_in, n_in > 0 ? in_sizes[0] : -1, out_size, ws_size); grid = -1; return; }
        int dev = 0, cus = 0, per_cu = 0;
        (void)hipGetDevice(&dev); (void)hipDeviceGetAttribute(&cus, hipDeviceAttributeMultiprocessorCount, dev);
        (void)hipFuncSetAttribute((const void*)fwd_kernel, hipFuncAttributeMaxDynamicSharedMemorySize, LDS_BYTES);
        (void)hipOccupancyMaxActiveBlocksPerMultiprocessor(&per_cu, (const void*)fwd_kernel, NTHREADS, LDS_BYTES);
        (void)hipGetLastError();
        if (per_cu < 1) per_cu = 1;
        grid = cus * (per_cu < 1 ? per_cu : 1);
    }
    if (grid < 0) return;
    (void)hipMemsetAsync((char*)d_ws + WS_CTL, 0, CTL_ZERO_BYTES, stream);
#ifndef PROBE_PHASE
#define PROBE_PHASE -1
#endif
#ifndef PROBE_REPS
#define PROBE_REPS 2
#endif
    Args a{};
    a.probe_phase = PROBE_PHASE; a.probe_reps = PROBE_REPS;
    for (int i = 0; i < 20; ++i) a.in[i] = (const float*)d_in[i];
    a.out = (float*)d_out; a.ws = (unsigned char*)d_ws;
#if defined(MK_PER_PHASE)
    for (int p = 0; p < N_PHASES; ++p) { a.ph_lo = p; a.ph_hi = p + 1; hipLaunchKernelGGL(fwd_kernel, dim3(grid), dim3(NTHREADS), LDS_BYTES, stream, a); }
#else
    a.ph_lo = 0; a.ph_hi = N_PHASES; hipLaunchKernelGGL(fwd_kernel, dim3(grid), dim3(NTHREADS), LDS_BYTES, stream, a);
#endif
}
```

```cpp
#include <hip/hip_runtime.h>
#include <cstdio>
#include <cstdint>

#define LAS __attribute__((address_space(3)))
typedef unsigned short bf16;
typedef short bf16x8 __attribute__((ext_vector_type(8)));
typedef short bf16x4 __attribute__((ext_vector_type(4)));
typedef float f32x4 __attribute__((ext_vector_type(4)));
typedef float f32x2 __attribute__((ext_vector_type(2)));
typedef unsigned u32x4 __attribute__((ext_vector_type(4)));
typedef unsigned u32x2 __attribute__((ext_vector_type(2)));
typedef __bf16 bf16x2_t __attribute__((ext_vector_type(2)));

constexpr int NB = 4, SEQ = 4096, D = 1024, FF = 4096, M = NB * SEQ, NMETA = 16;
constexpr int ZN0 = 1536;
constexpr int GN = 3072, GNR = 3088;
constexpr int NCH = SEQ / 64;
constexpr float EPS = 1e-5f;
constexpr int NTHREADS = 512, NWAVES = 8;

constexpr size_t MiB = 1u << 20;
constexpr size_t WS_CTL = 0, CTL_ZERO_BYTES = 1 * MiB;
constexpr size_t WS_SSQ = 1 * MiB;
constexpr size_t WS_R = 2 * MiB;
constexpr size_t WS_DTOT = 3 * MiB;
constexpr size_t WS_META = 4 * MiB;
constexpr size_t WS_W_IN0 = 5 * MiB, WS_W_OUT0 = 8 * MiB, WS_W1_0 = 10 * MiB, WS_W2_0 = 18 * MiB;
constexpr size_t WS_W_IN1 = 26 * MiB, WS_W_OUT1 = 33 * MiB, WS_W1_1 = 35 * MiB, WS_W2_1 = 43 * MiB;
constexpr size_t WS_HB = 52 * MiB;
constexpr size_t WS_S = 84 * MiB;
constexpr size_t WS_Z0 = WS_S, WS_MIX0 = WS_S + 48 * MiB;
constexpr size_t WS_A = WS_S;
constexpr size_t WS_Q = WS_S, WS_K = WS_S + 16 * MiB, WS_V = WS_S + 32 * MiB, WS_G = WS_S + 64 * MiB;
constexpr size_t WS_KDT = WS_S + 96 * MiB, WS_VT = WS_S + 112 * MiB;
constexpr size_t WS_O = WS_S + 96 * MiB;
constexpr size_t WS_END = WS_S + 144 * MiB;
static_assert(WS_END <= 256 * MiB, "workspace map");
constexpr size_t MT_HM = 0;
constexpr size_t MT_HBM = 64 * 1024;
constexpr size_t MT_ZM = 96 * 1024;
constexpr size_t MT_MIXM = 144 * 1024;
constexpr size_t MT_AM = 176 * 1024;
constexpr size_t MT_KM = 304 * 1024;
constexpr size_t MT_VM = 320 * 1024;
constexpr size_t MT_RM = 352 * 1024;
constexpr size_t MT_SSQM = 356 * 1024;
constexpr size_t MT_KDTM = 384 * 1024;
constexpr size_t MT_VTM = 448 * 1024;
static_assert(MT_VTM + 128 * 1024 <= MiB, "meta map");

constexpr int LDS_BYTES = 147456;

__device__ __forceinline__ float bf2f(bf16 b) { return __uint_as_float((unsigned)b << 16); }
__device__ __forceinline__ unsigned cvtpk(float lo, float hi) { f32x2 v = {lo, hi}; bf16x2_t b = __builtin_convertvector(v, bf16x2_t); return __builtin_bit_cast(unsigned, b); }
__device__ __forceinline__ bf16 f2bf(float f) { return (bf16)(cvtpk(f, 0.f) & 0xffffu); }
__device__ __forceinline__ float wave_sum(float v) {
#pragma unroll
    for (int o = 1; o < 64; o <<= 1) v += __shfl_xor(v, o);
    return v;
}
__device__ __forceinline__ float sigmoidf_(float x) { return __builtin_amdgcn_rcpf(1.0f + __expf(-x)); }
__device__ __forceinline__ float siluf_(float x) { return x * sigmoidf_(x); }
__device__ __forceinline__ float logsigmoidf_(float x) { return fminf(x, 0.f) - log1pf(__expf(-fabsf(x))); }
__host__ __device__ __forceinline__ int perm32(int rho) { const int n = rho >> 4, i = rho & 15; return 8 * (i >> 2) + 4 * n + (i & 3); }

struct Args { const float* in[20]; float* out; unsigned char* ws; int ph_lo, ph_hi, probe_phase, probe_reps; };

struct Ctx {
    const float* in[20]; float* out; unsigned char* ws;
    LAS unsigned char* lds;
    int tid, lane, wave, G, bid;
    __device__ __forceinline__ bf16* wsb(size_t off) const { return (bf16*)(ws + off); }
    __device__ __forceinline__ float* wsf(size_t off) const { return (float*)(ws + off); }
};

__device__ __forceinline__ void p0_transpose_item(const float* W, int K, int N, bf16* WT, const float* ksc, int qcols, float qsc, LAS float* scr, int item, int lane) {
    const int nblk = (N + 31) / 32, kb = item / nblk, nb = item % nblk, k0 = 64 * kb, n0 = 32 * nb;
    const bool nok = (n0 + (lane & 31)) < N;
#pragma unroll 8
    for (int i = 0; i < 32; ++i) { const int kk = 2 * i + (lane >> 5); float v = nok ? W[(size_t)(k0 + kk) * N + n0 + (lane & 31)] : 0.f; if (ksc) v *= ksc[k0 + kk]; scr[kk * 33 + (lane & 31)] = v; }
    asm volatile("s_waitcnt lgkmcnt(0)" ::: "memory");
    const int c = lane & 7;
#pragma unroll
    for (int j = 0; j < 4; ++j) { const int n = (lane >> 3) + 8 * j; const LAS float* s = scr + (8 * c) * 33 + n; const float sc = (n0 + n) < qcols ? qsc : 1.0f;
        u32x4 o; o.x = cvtpk(s[0 * 33] * sc, s[1 * 33] * sc); o.y = cvtpk(s[2 * 33] * sc, s[3 * 33] * sc); o.z = cvtpk(s[4 * 33] * sc, s[5 * 33] * sc); o.w = cvtpk(s[6 * 33] * sc, s[7 * 33] * sc);
        if (n0 + n < N) *(u32x4*)(WT + (size_t)(n0 + n) * K + k0 + 8 * c) = o; }
    asm volatile("s_waitcnt lgkmcnt(0)" ::: "memory");
}
__device__ __forceinline__ void p0_fold_item(const float* pw, const float* psc, const float* wo, bf16* WT, int item, int lane) {
    const int g = item >> 9, cb = (item >> 6) & 7, nb = item & 63, fr = lane & 15, fq = lane >> 4;
    const float* pa = pw + ((size_t)g * 128 + cb * 16 + fr) * 128 + fq;
    const float* sc = psc + g * 128 + fq;
    const float* pb = wo + ((size_t)(512 + g * 128 + fq)) * D + nb * 16 + fr;
    f32x4 acc = {0.f, 0.f, 0.f, 0.f};
#pragma unroll 8
    for (int db = 0; db < 32; ++db) { const float a = pa[4 * db] * sc[4 * db]; const float b = pb[(size_t)(4 * db) * D]; acc = __builtin_amdgcn_mfma_f32_16x16x4f32(a, b, acc, 0, 0, 0); }
    u32x2 o; o.x = cvtpk(acc[0], acc[1]); o.y = cvtpk(acc[2], acc[3]);
    *(u32x2*)(WT + (size_t)(nb * 16 + fr) * D + 512 + g * 128 + cb * 16 + 4 * fq) = o;
}
__device__ __forceinline__ void p0_row(const float* xrow, bf16* orow, float* ssq, int nslots, int lane) {
    const f32x4* xr = (const f32x4*)xrow + lane;
    f32x4 v[4]; float s = 0.f;
#pragma unroll
    for (int j = 0; j < 4; ++j) { v[j] = xr[64 * j]; s += (v[j].x * v[j].x + v[j].y * v[j].y) + (v[j].z * v[j].z + v[j].w * v[j].w); }
    s = wave_sum(s);
    u32x2* o8 = (u32x2*)orow + lane;
#pragma unroll
    for (int j = 0; j < 4; ++j) { u32x2 o; o.x = cvtpk(v[j].x, v[j].y); o.y = cvtpk(v[j].z, v[j].w); o8[64 * j] = o; }
    if (lane < nslots) ssq[lane] = lane == 0 ? s : 0.f;
}
__device__ __forceinline__ void phase_prologue(const Ctx& F) {
    LAS float* scr = (LAS float*)(F.lds + F.wave * 16384);
    const int gw = F.wave * F.G + F.bid, NGW = F.G * NWAVES;
    const float* mixg = F.in[2]; const float* ffng = F.in[3];
    constexpr int I_IN0 = (D / 64) * (ZN0 / 32), I_OUT0 = (512 / 64) * (D / 32), I_W1 = (D / 64) * (FF / 32), I_W2 = (FF / 64) * (D / 32);
    constexpr int I_IN1 = (D / 64) * ((GNR + 31) / 32), I_OUT1 = (D / 64) * (D / 32), I_FOLD = 4 * 8 * 64;
    constexpr int NITEMS = I_IN0 + I_OUT0 + 2 * I_W1 + 2 * I_W2 + I_IN1 + I_OUT1 + I_FOLD;
    for (int it = gw; it < NITEMS; it += NGW) {
        int r = it;
        if (r < I_IN0) { p0_transpose_item(F.in[6], D, ZN0, F.wsb(WS_W_IN0), mixg, 0, 1.f, scr, r, F.lane); continue; } r -= I_IN0;
        if (r < I_OUT0) { p0_transpose_item(F.in[13], D, D, F.wsb(WS_W_OUT0), nullptr, 0, 1.f, scr, r, F.lane); continue; } r -= I_OUT0;
        if (r < I_W1) { p0_transpose_item(F.in[4], D, FF, F.wsb(WS_W1_0), ffng, 0, 1.f, scr, r, F.lane); continue; } r -= I_W1;
        if (r < I_W1) { p0_transpose_item(F.in[4] + (size_t)D * FF, D, FF, F.wsb(WS_W1_1), ffng + D, 0, 1.f, scr, r, F.lane); continue; } r -= I_W1;
        if (r < I_W2) { p0_transpose_item(F.in[5], FF, D, F.wsb(WS_W2_0), nullptr, 0, 1.f, scr, r, F.lane); continue; } r -= I_W2;
        if (r < I_W2) { p0_transpose_item(F.in[5] + (size_t)FF * D, FF, D, F.wsb(WS_W2_1), nullptr, 0, 1.f, scr, r, F.lane); continue; } r -= I_W2;
        if (r < I_IN1) { p0_transpose_item(F.in[14], D, GNR, F.wsb(WS_W_IN1), mixg + D, 512, 0.08838834764831845f, scr, r, F.lane); continue; } r -= I_IN1;
        if (r < I_OUT1) { p0_transpose_item(F.in[18], D, D, F.wsb(WS_W_OUT1), nullptr, 0, 1.f, scr, r, F.lane); continue; } r -= I_OUT1;
        p0_fold_item(F.in[11], F.in[12], F.in[13], F.wsb(WS_W_OUT0), r, F.lane);
    }
    for (int m = gw; m < M + NMETA; m += NGW) {
        if (m < M) p0_row(F.in[0] + (size_t)m * D, F.wsb(WS_HB) + (size_t)m * D, F.wsf(WS_SSQ) + (size_t)m * 16, 16, F.lane);
        else { const int r = m - M; p0_row(F.in[1] + (size_t)r * D, F.wsb(WS_META + MT_HBM) + (size_t)r * D, F.wsf(WS_META + MT_SSQM) + (size_t)r * 64, 64, F.lane); }
    }
}

namespace pg8 {
#define PG8_LAS __attribute__((address_space(3)))
typedef unsigned short bf16_t;
typedef short bf16x8 __attribute__((ext_vector_type(8)));
typedef float f32x4 __attribute__((ext_vector_type(4)));
typedef unsigned u32x4 __attribute__((ext_vector_type(4)));
constexpr int BM = 256, BK = 64, HALF = 128, HTB = HALF * BK * 2  , STAGE_BYTES = 8 * HTB, NXCD = 8, WGM = 8;

__host__ __device__ __forceinline__ int lds_byte(int r, int c) { const int st = (r >> 4) * 2 + (c >> 5), rr = r & 15, cc = c & 31, ob = rr * 64 + cc * 2; return st * 1024 + (ob ^ (((ob >> 9) & 1) << 5)); }
__host__ __device__ __forceinline__ void stage_rc(int b, int& R, int& C) { const int st = b / 1024, sb = b % 1024, swz = sb ^ (((sb >> 9) & 1) << 5); R = (st >> 1) * 16 + swz / 64; C = (st & 1) * 32 + (swz % 64) / 2; }
__host__ __device__ __forceinline__ int perm32(int rho) { const int n = rho >> 4, i = rho & 15; return 8 * (i >> 2) + 4 * n + (i & 3); }

struct Unit { int pm, pn; };
struct Gemm { const bf16_t* A; const bf16_t* Bt; int M, N, K; };

struct StaticOrder {
    int nM, nN, nwg, G, c;
    __host__ __device__ void init(int M, int N, int G_, int c_) { nM = M / BM; nN = N / BM; nwg = nM * nN; G = G_; c = c_; }
    __host__ __device__ bool next(int i, Unit& u) const {
        const long L = (long)i * G + c; if (L >= nwg) return false;
        int wgid = (int)L; { const int q = nwg / NXCD, r = nwg % NXCD, xcd = wgid % NXCD, off = wgid / NXCD; wgid = (xcd < r ? xcd * (q + 1) : r * (q + 1) + (xcd - r) * q) + off; }
        const int nig = WGM * nN, gid = wgid / nig, fm = gid * WGM, gsz = (nM - fm) < WGM ? (nM - fm) : WGM;
        u.pm = fm + ((wgid % nig) % gsz); u.pn = (wgid % nig) / gsz; return true;
    }
    __device__ __forceinline__ void a_ready(const Unit&) const {}
    __device__ __forceinline__ void done(const Unit&) const {}
};

template <class Epi, class Sched, bool ALIGN_EPI = false, bool SP2 = false>
__device__ __forceinline__ void gemm_phase(PG8_LAS unsigned char* lds, const Gemm g, const Sched& S, const Epi& E) {
    const int tid = threadIdx.x, wid = __builtin_amdgcn_readfirstlane(tid >> 6), lane = tid & 63, wr = wid >> 2, wc = wid & 3, fr = lane & 15, fq = lane >> 4;
    const int K = g.K, nt = K / BK;
    unsigned voffA[2], voffB[2];
#pragma unroll
    for (int i = 0; i < 2; ++i) { int R, C; stage_rc(tid * 16 + i * 8192, R, C); const int Rb = Epi::PERM ? ((R & ~31) + perm32(R & 31)) : R;
        voffA[i] = (unsigned)(R * K + C) * 2u; voffB[i] = (unsigned)(Rb * K + C) * 2u; }
    const size_t kstep = (size_t)(BK * 2);
    const size_t hstep = (size_t)HALF * K * 2;
    const size_t tstep = 2 * hstep;
    const unsigned ldsw = (unsigned)wid * 1024u;
    const int aoff = lds_byte(wr * 64 + fr, fq * 8), boff = lds_byte(wc * 32 + fr, fq * 8);
#define PG8_SA(b, h) (((b) * 2 + (h)) * HTB)
#define PG8_SB(b, h) ((4 + (b) * 2 + (h)) * HTB)
#define PG8_STAGE(bufoff, gbase, voff) do { _Pragma("unroll") for (int _i = 0; _i < 2; ++_i) \
        __builtin_amdgcn_global_load_lds((const unsigned*)((const char*)(gbase) + (voff)[_i]), (PG8_LAS unsigned*)(lds + (bufoff) + ldsw + _i * 8192), 16, 0, 0); } while (0)
#define PG8_LDA(dst, b, h) do { _Pragma("unroll") for (int m = 0; m < 4; ++m) _Pragma("unroll") for (int k = 0; k < 2; ++k) dst[m][k] = *(const PG8_LAS bf16x8*)(lds + PG8_SA(b, h) + aoff + m * 2048 + k * 1024); } while (0)
#define PG8_LDB(dst, b, h) do { _Pragma("unroll") for (int n = 0; n < 2; ++n) _Pragma("unroll") for (int k = 0; k < 2; ++k) dst[n][k] = *(const PG8_LAS bf16x8*)(lds + PG8_SB(b, h) + boff + n * 2048 + k * 1024); } while (0)
#define PG8_MMA(ai, bj, At, Bt) do { __builtin_amdgcn_s_setprio(1); _Pragma("unroll") for (int m = 0; m < 4; ++m) _Pragma("unroll") for (int n = 0; n < 2; ++n) _Pragma("unroll") for (int k = 0; k < 2; ++k) \
        acc[ai][bj][m][n] = __builtin_amdgcn_mfma_f32_16x16x32_bf16(Bt[n][k], At[m][k], acc[ai][bj][m][n], 0, 0, 0); __builtin_amdgcn_s_setprio(0); } while (0)
#define PG8_WAIT_V(n) asm volatile("s_waitcnt vmcnt(" #n ")" ::: "memory")
#define PG8_WAIT_L(n) asm volatile("s_waitcnt lgkmcnt(" #n ")" ::: "memory")
#define PG8_BAR __builtin_amdgcn_s_barrier()
#define PG8_SCHED __builtin_amdgcn_sched_barrier(0)
    Unit cur, nxt; int ui = 0;
    if (!S.next(0, cur)) return;
    f32x4 acc[2][2][4][2];
#pragma unroll
    for (int a = 0; a < 2; ++a)
#pragma unroll
        for (int b = 0; b < 2; ++b)
#pragma unroll
            for (int m = 0; m < 4; ++m)
#pragma unroll
                for (int n = 0; n < 2; ++n) acc[a][b][m][n] = (f32x4){0.f, 0.f, 0.f, 0.f};
    bf16x8 At[4][2], B0[2][2], B1[2][2];
    const char* cA = (const char*)g.A + (size_t)cur.pm * tstep; const char* cB = (const char*)g.Bt + (size_t)cur.pn * tstep;
    S.a_ready(cur);
    if constexpr (SP2) {
        PG8_STAGE(PG8_SB(0, 0), cB, voffB); PG8_STAGE(PG8_SB(0, 1), cB + hstep, voffB); PG8_STAGE(PG8_SA(0, 0), cA, voffA); PG8_STAGE(PG8_SA(0, 1), cA + hstep, voffA);
        if (wr == 1) PG8_BAR;
        PG8_WAIT_V(2); PG8_BAR;
        PG8_STAGE(PG8_SB(1, 0), cB + kstep, voffB); PG8_STAGE(PG8_SA(1, 0), cA + kstep, voffA); PG8_STAGE(PG8_SB(1, 1), cB + hstep + kstep, voffB);
        PG8_WAIT_V(6); PG8_BAR;
    } else {
        PG8_STAGE(PG8_SB(0, 0), cB, voffB); PG8_STAGE(PG8_SA(0, 0), cA, voffA); PG8_STAGE(PG8_SB(0, 1), cB + hstep, voffB); PG8_STAGE(PG8_SA(0, 1), cA + hstep, voffA);
        if (wr == 1) PG8_BAR;
        PG8_WAIT_V(4); PG8_BAR;
        PG8_STAGE(PG8_SB(1, 0), cB + kstep, voffB); PG8_STAGE(PG8_SA(1, 0), cA + kstep, voffA); PG8_STAGE(PG8_SB(1, 1), cB + hstep + kstep, voffB);
        PG8_WAIT_V(6); PG8_BAR;
    }
    for (;;) {
        const bool has_next = S.next(ui + 1, nxt);
        const char* nA = has_next ? (const char*)g.A + (size_t)nxt.pm * tstep : cA; const char* nB = has_next ? (const char*)g.Bt + (size_t)nxt.pn * tstep : cB;
        for (int t = 0; t < nt; t += 2) {
            const bool last = (t == nt - 2);
            const char* a1 = cA + (size_t)(t + 1) * kstep;
            const char* a2 = last ? nA : cA + (size_t)(t + 2) * kstep; const char* b2 = last ? nB : cB + (size_t)(t + 2) * kstep;
            const char* a3 = a2 + kstep; const char* b3 = b2 + kstep;
            if (last && has_next) S.a_ready(nxt);
            if constexpr (SP2) {
            PG8_LDB(B0, 0, 0); PG8_LDB(B1, 0, 1); PG8_SCHED; PG8_LDA(At, 0, 0); PG8_STAGE(PG8_SA(1, 1), a1 + hstep, voffA);
            PG8_WAIT_V(8); PG8_WAIT_L(0); PG8_BAR; PG8_MMA(0, 0, At, B0); PG8_MMA(0, 1, At, B1); PG8_BAR; PG8_SCHED;
            PG8_LDA(At, 0, 1); PG8_STAGE(PG8_SB(0, 0), b2, voffB); PG8_STAGE(PG8_SB(0, 1), b2 + hstep, voffB); PG8_STAGE(PG8_SA(0, 0), a2, voffA);
            PG8_WAIT_V(8); PG8_WAIT_L(0); PG8_BAR; PG8_MMA(1, 0, At, B0); PG8_MMA(1, 1, At, B1); PG8_BAR; PG8_SCHED;
            PG8_LDB(B0, 1, 0); PG8_LDB(B1, 1, 1); PG8_SCHED; PG8_LDA(At, 1, 0); PG8_STAGE(PG8_SA(0, 1), a2 + hstep, voffA);
            PG8_WAIT_V(8); PG8_WAIT_L(0); PG8_BAR; PG8_MMA(0, 0, At, B0); PG8_MMA(0, 1, At, B1); PG8_BAR; PG8_SCHED;
            PG8_LDA(At, 1, 1); PG8_STAGE(PG8_SB(1, 0), b3, voffB); PG8_STAGE(PG8_SB(1, 1), b3 + hstep, voffB); PG8_STAGE(PG8_SA(1, 0), a3, voffA);
            PG8_WAIT_V(8); PG8_WAIT_L(0); PG8_BAR; PG8_MMA(1, 0, At, B0); PG8_MMA(1, 1, At, B1); PG8_BAR; PG8_SCHED;
            } else {
            PG8_LDB(B0, 0, 0); PG8_SCHED; PG8_LDA(At, 0, 0); PG8_STAGE(PG8_SA(1, 1), a1 + hstep, voffA);
            PG8_WAIT_L(8); PG8_BAR; PG8_WAIT_L(0); PG8_MMA(0, 0, At, B0); PG8_BAR; PG8_SCHED;
            PG8_LDB(B1, 0, 1); PG8_STAGE(PG8_SB(0, 0), b2, voffB);
            PG8_BAR; PG8_WAIT_L(0); PG8_MMA(0, 1, At, B1); PG8_BAR;
            PG8_LDA(At, 0, 1); PG8_STAGE(PG8_SA(0, 0), a2, voffA);
            PG8_BAR; PG8_WAIT_L(0); PG8_MMA(1, 0, At, B0); PG8_BAR; PG8_SCHED;
            PG8_STAGE(PG8_SB(0, 1), b2 + hstep, voffB);
            PG8_WAIT_V(6); PG8_BAR; PG8_MMA(1, 1, At, B1); PG8_BAR;
            PG8_LDB(B0, 1, 0); PG8_SCHED; PG8_LDA(At, 1, 0); PG8_STAGE(PG8_SA(0, 1), a2 + hstep, voffA);
            PG8_WAIT_L(8); PG8_BAR; PG8_WAIT_L(0); PG8_MMA(0, 0, At, B0); PG8_BAR; PG8_SCHED;
            PG8_LDB(B1, 1, 1); PG8_STAGE(PG8_SB(1, 0), b3, voffB);
            PG8_BAR; PG8_WAIT_L(0); PG8_MMA(0, 1, At, B1); PG8_BAR;
            PG8_LDA(At, 1, 1); PG8_STAGE(PG8_SA(1, 0), a3, voffA);
            PG8_BAR; PG8_WAIT_L(0); PG8_MMA(1, 0, At, B0); PG8_BAR; PG8_SCHED;
            PG8_STAGE(PG8_SB(1, 1), b3 + hstep, voffB);
            PG8_WAIT_V(6); PG8_BAR; PG8_MMA(1, 1, At, B1); PG8_BAR;
            }
        }
        if constexpr (ALIGN_EPI) { if (wr == 0) PG8_BAR; }
        if constexpr (!Epi::AFTER_DRAIN) { E(acc, cur, wr, wc, fr, fq); S.done(cur); }
        if (!has_next) break;
#pragma unroll
        for (int a = 0; a < 2; ++a)
#pragma unroll
            for (int b = 0; b < 2; ++b)
#pragma unroll
                for (int m = 0; m < 4; ++m)
#pragma unroll
                    for (int n = 0; n < 2; ++n) acc[a][b][m][n] = (f32x4){0.f, 0.f, 0.f, 0.f};
        cur = nxt; cA = nA; cB = nB; ++ui;
        if constexpr (ALIGN_EPI) { if (wr == 1) PG8_BAR; }
    }
    PG8_WAIT_V(0);
    if constexpr (!ALIGN_EPI) { if (wr == 0) PG8_BAR; }
    PG8_BAR;
    if constexpr (Epi::AFTER_DRAIN) { E.fused(acc, cur, wr, wc, fr, fq, lds, wid, lane); S.done(cur); }
#undef PG8_SA
#undef PG8_SB
#undef PG8_STAGE
#undef PG8_LDA
#undef PG8_LDB
#undef PG8_MMA
#undef PG8_WAIT_V
#undef PG8_WAIT_L
#undef PG8_BAR
#undef PG8_SCHED
}
}

typedef pg8::Unit Unit;
typedef f32x4 Acc[2][2][4][2];

__device__ __forceinline__ void load_rs(const float* ssq, const Unit& u, int wr, int fr, int fq, float (&rs)[2][4]) {
#pragma unroll
    for (int ai = 0; ai < 2; ++ai)
#pragma unroll
        for (int m = 0; m < 4; ++m) { const int row = u.pm * 256 + ai * 128 + wr * 64 + m * 16 + fr;
            const f32x4 p = *(const f32x4*)(ssq + (size_t)row * 16 + 4 * fq); float s = (p.x + p.y) + (p.z + p.w);
            s += __shfl_xor(s, 16); s += __shfl_xor(s, 32); rs[ai][m] = rsqrtf(s * (1.0f / D) + EPS); }
}
template <int ACT, int SPLIT> struct EpiBf16S {
    static constexpr bool PERM = true, AFTER_DRAIN = false;
    const float* ssq; bf16* O; int ldc; bf16 *Q, *K, *V, *Gt;
    __device__ __forceinline__ void operator()(const Acc& acc, const Unit& u, int wr, int wc, int fr, int fq) const {
        float rs[2][4]; load_rs(ssq, u, wr, fr, fq, rs);
        bf16* base = O; int ld = ldc, colt = u.pn * 256;
        if (SPLIT) { if (u.pn < 2) { base = Q; ld = 512; } else if (u.pn < 4) { base = K; ld = 512; colt -= 512; } else if (u.pn < 8) { base = V; ld = 1024; colt -= 1024; } else { base = Gt; ld = 1024; colt -= 2048; } }
        const int row0 = u.pm * 256 + wr * 64 + fr, col0 = colt + wc * 32 + 8 * fq;
#pragma unroll
        for (int ai = 0; ai < 2; ++ai)
#pragma unroll
            for (int m = 0; m < 4; ++m) { bf16* rowp = base + (size_t)(row0 + ai * 128 + m * 16) * ld + col0; const float s = rs[ai][m];
#pragma unroll
                for (int bj = 0; bj < 2; ++bj) { f32x4 v0 = acc[ai][bj][m][0] * s, v1 = acc[ai][bj][m][1] * s;
                    if (ACT == 1) {
#pragma unroll
                        for (int e = 0; e < 4; ++e) { const float a = fmaxf(v0[e], 0.f), b = fmaxf(v1[e], 0.f); v0[e] = a * a; v1[e] = b * b; } }
                    u32x4 w; w.x = cvtpk(v0[0], v0[1]); w.y = cvtpk(v0[2], v0[3]); w.z = cvtpk(v1[0], v1[1]); w.w = cvtpk(v1[2], v1[3]);
                    *(u32x4*)(rowp + bj * 128) = w; } }
    }
};
template <bool BASE_F32> struct EpiResid {
    static constexpr bool PERM = true, AFTER_DRAIN = false;
    const float* basef; bf16* hb; float* ssq;
    __device__ __forceinline__ void operator()(const Acc& acc, const Unit& u, int wr, int wc, int fr, int fq) const {
        const int row0 = u.pm * 256 + wr * 64 + fr, col0 = u.pn * 256 + wc * 32 + 8 * fq;
#pragma unroll
        for (int ai = 0; ai < 2; ++ai)
#pragma unroll
            for (int m = 0; m < 4; ++m) { const int row = row0 + ai * 128 + m * 16; const size_t off = (size_t)row * D + col0; float ss = 0.f;
#pragma unroll
                for (int bj = 0; bj < 2; ++bj) { f32x4 b0, b1;
                    if (BASE_F32) { b0 = *(const f32x4*)(basef + off + bj * 128); b1 = *(const f32x4*)(basef + off + bj * 128 + 4); }
                    else { const u32x4 hv = *(const u32x4*)(hb + off + bj * 128);
                        b0 = (f32x4){__uint_as_float(hv.x << 16), __uint_as_float(hv.x & 0xffff0000u), __uint_as_float(hv.y << 16), __uint_as_float(hv.y & 0xffff0000u)};
                        b1 = (f32x4){__uint_as_float(hv.z << 16), __uint_as_float(hv.z & 0xffff0000u), __uint_as_float(hv.w << 16), __uint_as_float(hv.w & 0xffff0000u)}; }
                    const f32x4 v0 = acc[ai][bj][m][0] + b0, v1 = acc[ai][bj][m][1] + b1;
                    u32x4 w; w.x = cvtpk(v0[0], v0[1]); w.y = cvtpk(v0[2], v0[3]); w.z = cvtpk(v1[0], v1[1]); w.w = cvtpk(v1[2], v1[3]);
                    *(u32x4*)(hb + off + bj * 128) = w;
                    ss += (v0[0] * v0[0] + v0[1] * v0[1]) + (v0[2] * v0[2] + v0[3] * v0[3]) + (v1[0] * v1[0] + v1[1] * v1[1]) + (v1[2] * v1[2] + v1[3] * v1[3]); }
                ss += __shfl_xor(ss, 16); ss += __shfl_xor(ss, 32);
                if (fq == 0) ssq[(size_t)row * 16 + u.pn * 4 + wc] = ss; }
    }
};

template <class Epi> __device__ __forceinline__ void gemm_slow(const Ctx& F, const bf16* A, const bf16* Bt, int Mr, int N, int K, const Epi& E) {
    const int wr = F.wave >> 2, wc = F.wave & 3, fr = F.lane & 15, fq = F.lane >> 4;
    const int nM = Mr / 256, nN = N / 256;
    for (int un = F.bid; un < nM * nN; un += F.G) {
        Unit u; u.pm = un / nN; u.pn = un % nN;
        Acc acc;
#pragma unroll
        for (int a = 0; a < 2; ++a)
#pragma unroll
            for (int b = 0; b < 2; ++b)
#pragma unroll
                for (int m = 0; m < 4; ++m)
#pragma unroll
                    for (int n = 0; n < 2; ++n) acc[a][b][m][n] = (f32x4){0.f, 0.f, 0.f, 0.f};
        const bf16* ap = A + (size_t)(u.pm * 256 + wr * 64 + fr) * K + 8 * fq;
        const bf16* bp0 = Bt + (size_t)(u.pn * 256 + wc * 32 + perm32(fr)) * K + 8 * fq;
        const bf16* bp1 = Bt + (size_t)(u.pn * 256 + wc * 32 + perm32(16 + fr)) * K + 8 * fq;
        for (int k0 = 0; k0 < K; k0 += 32) {
            bf16x8 a[2][4], b[2][2];
#pragma unroll
            for (int ai = 0; ai < 2; ++ai)
#pragma unroll
                for (int m = 0; m < 4; ++m) a[ai][m] = *(const bf16x8*)(ap + (size_t)(ai * 128 + m * 16) * K + k0);
#pragma unroll
            for (int bj = 0; bj < 2; ++bj) { b[bj][0] = *(const bf16x8*)(bp0 + (size_t)(bj * 128) * K + k0); b[bj][1] = *(const bf16x8*)(bp1 + (size_t)(bj * 128) * K + k0); }
#pragma unroll
            for (int ai = 0; ai < 2; ++ai)
#pragma unroll
                for (int bj = 0; bj < 2; ++bj)
#pragma unroll
                    for (int m = 0; m < 4; ++m)
#pragma unroll
                        for (int n = 0; n < 2; ++n) acc[ai][bj][m][n] = __builtin_amdgcn_mfma_f32_16x16x32_bf16(b[bj][n], a[ai][m], acc[ai][bj][m][n], 0, 0, 0);
        }
        E(acc, u, wr, wc, fr, fq);
    }
}


#ifndef USE_SLOW_GEMM
#define USE_SLOW_GEMM 0
#endif
template <class Epi> __device__ __forceinline__ void gemm_run(const Ctx& F, const bf16* A, const bf16* Bt, int Mr, int N, int K, const Epi& E) {
#if USE_SLOW_GEMM
    gemm_slow(F, A, Bt, Mr, N, K, E);
#else
    pg8::Gemm g{A, Bt, Mr, N, K}; pg8::StaticOrder S; S.init(Mr, N, F.G, F.bid);
    pg8::gemm_phase<Epi, pg8::StaticOrder, true, true>(F.lds, g, S, E);
#endif
}
__device__ __forceinline__ f32x4 skinny_task(const bf16* A, int lda, const bf16* Bt, int ldb, int K, int lane) {
    const int fr = lane & 15, fq = lane >> 4;
    const bf16* ap = A + (size_t)fr * lda + 8 * fq; const bf16* bp = Bt + (size_t)fr * ldb + 8 * fq;
    f32x4 acc = {0.f, 0.f, 0.f, 0.f};
#pragma unroll 8
    for (int k = 0; k < K; k += 32) { const bf16x8 a = *(const bf16x8*)(ap + k), b = *(const bf16x8*)(bp + k); acc = __builtin_amdgcn_mfma_f32_16x16x32_bf16(b, a, acc, 0, 0, 0); }
    return acc;
}
__device__ __forceinline__ float meta_rs(const float* ssqm, int lane) {
    const int fr = lane & 15, fq = lane >> 4; const f32x4* p = (const f32x4*)(ssqm + fr * 64 + 16 * fq); float s = 0.f;
#pragma unroll
    for (int j = 0; j < 4; ++j) { const f32x4 v = p[j]; s += (v.x + v.y) + (v.z + v.w); }
    s += __shfl_xor(s, 16); s += __shfl_xor(s, 32); return rsqrtf(s * (1.0f / D) + EPS);
}
__device__ __forceinline__ int meta_task_id(const Ctx& F) { return F.wave * F.G + F.bid; }
template <int ACT> __device__ __forceinline__ void meta_scale_gemm(const Ctx& F, const bf16* Wt, int N, int K, bf16* O) {
    const bf16* hbm = F.wsb(WS_META + MT_HBM); const float* ssqm = F.wsf(WS_META + MT_SSQM);
    for (int t = meta_task_id(F); t < N / 16; t += F.G * NWAVES) {
        const float rs = meta_rs(ssqm, F.lane); f32x4 acc = skinny_task(hbm, D, Wt + (size_t)t * 16 * K, K, K, F.lane) * rs;
        if (ACT == 1) {
#pragma unroll
            for (int e = 0; e < 4; ++e) { const float a = fmaxf(acc[e], 0.f); acc[e] = a * a; } }
        u32x2 o; o.x = cvtpk(acc[0], acc[1]); o.y = cvtpk(acc[2], acc[3]);
        *(u32x2*)(O + (size_t)(F.lane & 15) * N + t * 16 + 4 * (F.lane >> 4)) = o;
    }
}
__device__ __forceinline__ void meta_resid_gemm(const Ctx& F, const bf16* A16, int K, const bf16* Wt, const float* base) {
    float* hm = F.wsf(WS_META + MT_HM); bf16* hbm = F.wsb(WS_META + MT_HBM); float* ssqm = F.wsf(WS_META + MT_SSQM);
    for (int t = meta_task_id(F); t < D / 16; t += F.G * NWAVES) {
        const int fr = F.lane & 15, fq = F.lane >> 4; const size_t off = (size_t)fr * D + t * 16 + 4 * fq;
        f32x4 acc = skinny_task(A16, K, Wt + (size_t)t * 16 * K, K, K, F.lane);
        const f32x4 v = acc + *(const f32x4*)(base + off);
        *(f32x4*)(hm + off) = v; u32x2 o; o.x = cvtpk(v[0], v[1]); o.y = cvtpk(v[2], v[3]);
        float ss = (v[0] * v[0] + v[1] * v[1]) + (v[2] * v[2] + v[3] * v[3]); ss += __shfl_xor(ss, 16); ss += __shfl_xor(ss, 32);
        *(u32x2*)(hbm + off) = o; if (fq == 0) ssqm[fr * 64 + t] = ss;
    }
}

template <int W> __device__ __forceinline__ void pool_block(const Ctx& F, float (&pw)[47], int t0s, int c, bf16* mixrow0, bool meta_unit) {
#pragma unroll
    for (int i = 0; i < 32; ++i) {
        float s = 0.f;
#pragma unroll
        for (int j = 0; j < W; ++j) s += pw[15 + i - j];
        const int tg = t0s + i + NMETA; const int cnt = tg + 1 < W ? tg + 1 : W;
        const float v = s * (1.0f / (float)cnt) - pw[15 + i];
        const bool st = meta_unit ? (i < 16) : true;
        if (st) mixrow0[(size_t)i * D + 512 + c] = f2bf(v);
    }
}
__device__ __forceinline__ void phase_convpool(const Ctx& F) {
    const int c = F.tid;
    const float* cw = F.in[7]; float w[31];
#pragma unroll
    for (int j = 0; j < 31; ++j) w[j] = cw[j * 512 + c];
    const float cb = F.in[8][c];
    const float* lng = F.in[9]; const float* lnb = F.in[10];
    const bf16* Z0 = F.wsb(WS_Z0); const bf16* ZM = F.wsb(WS_META + MT_ZM);
    bf16* MIX0 = F.wsb(WS_MIX0); bf16* MIXM = F.wsb(WS_META + MT_MIXM);
    LAS float* Y = (LAS float*)F.lds;
    const int g = c >> 7;
    for (int un = F.bid; un < 257; un += F.G) {
        const bool meta_unit = un == 256; const int b = meta_unit ? 0 : un >> 6; const int t0 = meta_unit ? -16 : (un & 63) * 64;
        float win[62], pw[47];
        for (int sb = 0; sb < (meta_unit ? 1 : 2); ++sb) {
            const int t0s = t0 + 32 * sb;
#pragma unroll
            for (int j = 0; j < 62; ++j) {
                if (sb == 1 && j < 30) { win[j] = win[j + 32]; continue; }
                const int t = t0s - 30 + j; float v = 0.f;
                if (t >= -NMETA) { const bf16* zr = t >= 0 ? Z0 + ((size_t)b * SEQ + t) * ZN0 : ZM + (size_t)(t + NMETA) * ZN0; v = bf2f(zr[c]) * sigmoidf_(bf2f(zr[512 + c])); }
                win[j] = v;
            }
#pragma unroll
            for (int j = 0; j < 47; ++j) {
                if (sb == 1 && j < 15) { pw[j] = pw[j + 32]; continue; }
                const int t = t0s - 15 + j; float v = 0.f;
                if (t >= -NMETA) { const bf16* zr = t >= 0 ? Z0 + ((size_t)b * SEQ + t) * ZN0 : ZM + (size_t)(t + NMETA) * ZN0; v = bf2f(zr[1024 + c]); }
                pw[j] = v;
            }
#pragma unroll
            for (int i = 0; i < 32; ++i) { float y = cb;
#pragma unroll
                for (int j = 0; j < 31; ++j) y = fmaf(w[j], win[i + j], y);
                Y[i * 512 + c] = y; }
            __syncthreads();
#pragma unroll
            for (int rr = 0; rr < 4; ++rr) {
                const int i = F.wave * 4 + rr; const int t = t0s + i;
                const f32x4 y0 = *(const LAS f32x4*)(Y + i * 512 + 8 * F.lane), y1 = *(const LAS f32x4*)(Y + i * 512 + 8 * F.lane + 4);
                const float mean = wave_sum((y0.x + y0.y) + (y0.z + y0.w) + (y1.x + y1.y) + (y1.z + y1.w)) * (1.0f / 512.0f);
                const f32x4 d0 = y0 - mean, d1 = y1 - mean;
                const float var = wave_sum((d0.x * d0.x + d0.y * d0.y) + (d0.z * d0.z + d0.w * d0.w) + (d1.x * d1.x + d1.y * d1.y) + (d1.z * d1.z + d1.w * d1.w)) * (1.0f / 512.0f);
                const float rstd = rsqrtf(var + EPS);
                const f32x4 g0 = *(const f32x4*)(lng + 8 * F.lane), g1 = *(const f32x4*)(lng + 8 * F.lane + 4), b0 = *(const f32x4*)(lnb + 8 * F.lane), b1 = *(const f32x4*)(lnb + 8 * F.lane + 4);
                f32x4 o0, o1;
#pragma unroll
                for (int e = 0; e < 4; ++e) { o0[e] = siluf_(d0[e] * rstd * g0[e] + b0[e]); o1[e] = siluf_(d1[e] * rstd * g1[e] + b1[e]); }
                u32x4 wv; wv.x = cvtpk(o0[0], o0[1]); wv.y = cvtpk(o0[2], o0[3]); wv.z = cvtpk(o1[0], o1[1]); wv.w = cvtpk(o1[2], o1[3]);
                const bool st = meta_unit ? (t < 0) : true;
                bf16* orow = t >= 0 ? MIX0 + ((size_t)b * SEQ + t) * D : MIXM + (size_t)(t + NMETA) * D;
                if (st) *(u32x4*)(orow + 8 * F.lane) = wv;
            }
            {
                bf16* mixrow0 = t0s >= 0 ? MIX0 + ((size_t)b * SEQ + t0s) * D : MIXM + (size_t)(t0s + NMETA) * D;
                if (g == 0) pool_block<2>(F, pw, t0s, c, mixrow0, meta_unit);
                else if (g == 1) pool_block<4>(F, pw, t0s, c, mixrow0, meta_unit);
                else if (g == 2) pool_block<8>(F, pw, t0s, c, mixrow0, meta_unit);
                else pool_block<16>(F, pw, t0s, c, mixrow0, meta_unit);
            }
            __syncthreads();
        }
    }
}

__device__ __forceinline__ float logsig_fast(float x) { return fminf(x, 0.f) - 0.6931471805599453f * __log2f(1.0f + __expf(-fabsf(x))); }
__device__ __forceinline__ void phase_prep(const Ctx& F) {
    const int p = F.tid & 255, hh = F.tid >> 8;
    const float* w2p = F.in[15]; f32x2 w2[16];
#pragma unroll
    for (int j = 0; j < 16; ++j) w2[j] = *(const f32x2*)(w2p + j * 512 + 2 * p);
    const f32x2 gb = *(const f32x2*)(F.in[16] + 2 * p);
    LAS float* rl = (LAS float*)F.lds;
    LAS float* th = (LAS float*)(F.lds + 4096);
    LAS float* lat = (LAS float*)(F.lds + 8192);
    for (int un = F.bid; un < 257; un += F.G) {
        const bool meta_unit = un == 256; const int nv = meta_unit ? 16 : 64;
        const size_t row0 = meta_unit ? 0 : (size_t)un * 64;
        const float* Rp = meta_unit ? F.wsf(WS_META + MT_RM) : F.wsf(WS_R) + row0 * 16;
        bf16* Kp = (meta_unit ? F.wsb(WS_META + MT_KM) : F.wsb(WS_K) + row0 * 512) + 2 * p;
        __syncthreads();
        for (int i = F.tid; i < nv * 16; i += NTHREADS) rl[i] = Rp[i];
        __syncthreads();
        float ra = 0.f, rb = 0.f;
#pragma unroll 2
        for (int cc = 0; cc < 32; ++cc) { const int c = 32 * hh + cc; f32x2 la = {0.f, 0.f};
            if (c < nv) { float pa = gb.x, pb = gb.y;
#pragma unroll
                for (int j4 = 0; j4 < 4; ++j4) { const f32x4 r4 = *(const LAS f32x4*)(rl + c * 16 + 4 * j4);
#pragma unroll
                    for (int e = 0; e < 4; ++e) { pa = fmaf(r4[e], w2[4 * j4 + e].x, pa); pb = fmaf(r4[e], w2[4 * j4 + e].y, pb); } }
                la.x = logsig_fast(pa) * (1.0f / 16.0f); la.y = logsig_fast(pb) * (1.0f / 16.0f); }
            ra += la.x; rb += la.y; *(LAS f32x2*)(lat + c * 512 + 2 * p) = la; }
        th[hh * 512 + 2 * p] = ra; th[hh * 512 + 2 * p + 1] = rb;
        __syncthreads();
        const float t0a = th[2 * p], t0b = th[2 * p + 1], t1a = th[512 + 2 * p], t1b = th[512 + 2 * p + 1];
        const float tota = t0a + t1a, totb = t0b + t1b;
        float resta = hh ? t1a : tota, restb = hh ? t1b : totb;
        if (!meta_unit && hh == 0) *(f32x2*)(F.wsf(WS_DTOT) + (size_t)un * 512 + 2 * p) = (f32x2){__expf(tota), __expf(totb)};
#pragma unroll 8
        for (int cc = 0; cc < 32; ++cc) { const int c = 32 * hh + cc;
            if (c < nv) { const unsigned kr = *(const unsigned*)(Kp + (size_t)c * 512); const f32x2 la = *(const LAS f32x2*)(lat + c * 512 + 2 * p);
                resta -= la.x; restb -= la.y;
                *(unsigned*)(Kp + (size_t)c * 512) = cvtpk(__uint_as_float(kr << 16) * __expf(resta), __uint_as_float(kr & 0xffff0000u) * __expf(restb)); } }
    }
}

typedef short v4i16_t __attribute__((ext_vector_type(4)));
__device__ __forceinline__ bf16x4 lds_tr16(const LAS unsigned char* p) { return __builtin_bit_cast(bf16x4, __builtin_amdgcn_ds_read_tr16_b64_v4i16((LAS v4i16_t*)p)); }
__device__ __forceinline__ unsigned swz_b(unsigned row) { return ((row & 3u) << 2) | ((row >> 2) & 3u); }
__device__ __forceinline__ unsigned off_b(unsigned row, unsigned ch) { return 256u * row + 16u * (ch ^ swz_b(row)); }
constexpr int SC_KD = 0, SC_Q = 32768, SC_V = 65536, SC_PART = 69632, SC_PSTR = 68;
static_assert(SC_PART + 2 * 8 * 16 * SC_PSTR * 4 <= 146944, "scan LDS map");
struct ScanRegs { u32x4 kd[2], q[2], v; f32x4 d; };
__device__ __forceinline__ void phase_scan(const Ctx& F) {
    const int fr = F.lane & 15, fq = F.lane >> 4, w = F.wave, tid = F.tid;
    LAS unsigned char* lds = F.lds;
    LAS float* part = (LAS float*)(lds + SC_PART);
    const unsigned q_ = (unsigned)(F.lane & 15) >> 2, p_ = (unsigned)F.lane & 3u;
    unsigned tra[2][2], trv[2][2];
#pragma unroll
    for (int ks = 0; ks < 2; ++ks)
#pragma unroll
        for (int t = 0; t < 2; ++t) { const unsigned row = 32u * ks + 8u * fq + 4u * t + q_; tra[ks][t] = off_b(row, 2u * w + (p_ >> 1)) + 8u * (p_ & 1u); trv[ks][t] = row * 32u + 8u * p_; }
    const unsigned qch_ = 2u * w + ((unsigned)fq >> 1), qlo_ = 8u * ((unsigned)fq & 1u);
    const unsigned qoff0 = off_b(fr, qch_) + qlo_, qoff1 = off_b(16u + fr, qch_) + qlo_, qoff2 = off_b(32u + fr, qch_) + qlo_, qoff3 = off_b(48u + fr, qch_) + qlo_;
    unsigned grow[2], gch[2];
#pragma unroll
    for (int i = 0; i < 2; ++i) { const unsigned id = tid + 512u * i, row = id >> 4, chp = id & 15u; grow[i] = row; gch[i] = chp ^ swz_b(row); }
    const bool vth = tid < 128; const unsigned vrow = ((unsigned)tid & 127u) >> 1, vch = (unsigned)tid & 1u;
    for (int un = F.bid; un < 256; un += F.G) {
        const int xcd = un & 7, idx = un >> 3, pair = xcd * 2 + (idx >> 4), vs = idx & 15, b = pair >> 2, h = pair & 3;
        const bf16* Kb = F.wsb(WS_K) + (size_t)b * SEQ * 512 + h * 128;
        const bf16* Qb = F.wsb(WS_Q) + (size_t)b * SEQ * 512 + h * 128;
        const bf16* Vb = F.wsb(WS_V) + (size_t)b * SEQ * D + h * 256 + vs * 16;
        const float* DT = F.wsf(WS_DTOT) + (size_t)b * NCH * 512 + h * 128 + 16 * w + 4 * fq;
        bf16* Ob = F.wsb(WS_O) + (size_t)b * SEQ * D + h * 256 + vs * 16;
        f32x4 S = {0.f, 0.f, 0.f, 0.f};
        ScanRegs R0, R1, R2, R3;
#define SC_LOAD(R, n) do { const size_t t0_ = (size_t)(n) * 64; \
            _Pragma("unroll") for (int i = 0; i < 2; ++i) { (R).kd[i] = *(const u32x4*)(Kb + (t0_ + grow[i]) * 512 + gch[i] * 8); (R).q[i] = *(const u32x4*)(Qb + (t0_ + grow[i]) * 512 + gch[i] * 8); } \
            (R).v = *(const u32x4*)(Vb + (t0_ + vrow) * D + vch * 8); \
            (R).d = *(const f32x4*)(DT + (size_t)(n) * 512); } while (0)
#define SC_WRITE(R, buf) do { \
            _Pragma("unroll") for (int i = 0; i < 2; ++i) { *(LAS u32x4*)(lds + SC_KD + (buf) * 16384 + 16 * (tid + 512 * i)) = (R).kd[i]; *(LAS u32x4*)(lds + SC_Q + (buf) * 16384 + 16 * (tid + 512 * i)) = (R).q[i]; } \
            if (vth) *(LAS u32x4*)(lds + SC_V + (buf) * 2048 + 16 * tid) = (R).v; } while (0)
#define SC_UPDATE(buf) do { \
            const LAS unsigned char* kt_ = lds + SC_KD + (buf) * 16384; const LAS unsigned char* vt_ = lds + SC_V + (buf) * 2048; \
            const bf16x4 a00 = lds_tr16(kt_ + tra[0][0]), a01 = lds_tr16(kt_ + tra[0][1]), a10 = lds_tr16(kt_ + tra[1][0]), a11 = lds_tr16(kt_ + tra[1][1]); \
            const bf16x4 b00 = lds_tr16(vt_ + trv[0][0]), b01 = lds_tr16(vt_ + trv[0][1]), b10 = lds_tr16(vt_ + trv[1][0]), b11 = lds_tr16(vt_ + trv[1][1]); \
            const bf16x8 a0 = __builtin_shufflevector(a00, a01, 0, 1, 2, 3, 4, 5, 6, 7), a1 = __builtin_shufflevector(a10, a11, 0, 1, 2, 3, 4, 5, 6, 7); \
            const bf16x8 b0 = __builtin_shufflevector(b00, b01, 0, 1, 2, 3, 4, 5, 6, 7), b1 = __builtin_shufflevector(b10, b11, 0, 1, 2, 3, 4, 5, 6, 7); \
            S = __builtin_amdgcn_mfma_f32_16x16x32_bf16(a0, b0, S, 0, 0, 0); S = __builtin_amdgcn_mfma_f32_16x16x32_bf16(a1, b1, S, 0, 0, 0); } while (0)
        SC_LOAD(R0, 0); SC_LOAD(R1, 1); SC_LOAD(R2, 2); SC_LOAD(R3, 3);
        {
            const bf16* KM = F.wsb(WS_META + MT_KM) + h * 128; const bf16* VM = F.wsb(WS_META + MT_VM) + h * 256 + vs * 16;
#pragma unroll
            for (int i = 0; i < 2; ++i) { u32x4 z = {0u, 0u, 0u, 0u}; if (grow[i] < 16u) z = *(const u32x4*)(KM + (size_t)grow[i] * 512 + gch[i] * 8); *(LAS u32x4*)(lds + SC_KD + 16384 + 16 * (tid + 512 * i)) = z; }
            if (vth) { u32x4 z = {0u, 0u, 0u, 0u}; if (vrow < 16u) z = *(const u32x4*)(VM + (size_t)vrow * D + vch * 8); *(LAS u32x4*)(lds + SC_V + 2048 + 16 * tid) = z; }
            __syncthreads();
            SC_UPDATE(1);
        }
        SC_WRITE(R0, 0);
        __syncthreads();
#define SC_STEP(R, RN, n) do { const int n_ = (n); const int buf_ = n_ & 1; \
            const LAS unsigned char* qt_ = lds + SC_Q + buf_ * 16384; \
            const bf16x4 qa0_ = *(const LAS bf16x4*)(qt_ + qoff0), qa1_ = *(const LAS bf16x4*)(qt_ + qoff1), qa2_ = *(const LAS bf16x4*)(qt_ + qoff2), qa3_ = *(const LAS bf16x4*)(qt_ + qoff3); \
            S = S * (R).d; SC_UPDATE(buf_); \
            { u32x2 sb2; sb2.x = cvtpk(S[0], S[1]); sb2.y = cvtpk(S[2], S[3]); const bf16x4 sb = __builtin_bit_cast(bf16x4, sb2); \
              LAS float* pw = part + ((size_t)(buf_ * 8 + w) * 16 + fr) * SC_PSTR + 4 * fq; \
              const f32x4 z4_ = {0.f, 0.f, 0.f, 0.f}; \
              const f32x4 o0_ = __builtin_amdgcn_mfma_f32_16x16x16bf16_1k(qa0_, sb, z4_, 0, 0, 0), o1_ = __builtin_amdgcn_mfma_f32_16x16x16bf16_1k(qa1_, sb, z4_, 0, 0, 0); \
              const f32x4 o2_ = __builtin_amdgcn_mfma_f32_16x16x16bf16_1k(qa2_, sb, z4_, 0, 0, 0), o3_ = __builtin_amdgcn_mfma_f32_16x16x16bf16_1k(qa3_, sb, z4_, 0, 0, 0); \
              *(LAS f32x4*)(pw) = o0_; *(LAS f32x4*)(pw + 16) = o1_; *(LAS f32x4*)(pw + 32) = o2_; *(LAS f32x4*)(pw + 48) = o3_; } \
            SC_WRITE(RN, buf_ ^ 1); \
            SC_LOAD(R, (n_ + 4 < NCH ? n_ + 4 : NCH - 1)); \
            __syncthreads(); \
            { const int c = tid >> 3, v2 = (tid & 7) * 2; float s0 = 0.f, s1 = 0.f; \
              _Pragma("unroll") for (int ww = 0; ww < 8; ++ww) { const LAS float* pr = part + ((size_t)(buf_ * 8 + ww) * 16 + v2) * SC_PSTR + c; s0 += pr[0]; s1 += pr[SC_PSTR]; } \
              *(unsigned*)(Ob + (size_t)(n_ * 64 + c) * D + v2) = cvtpk(s0, s1); } } while (0)
        for (int n0 = 0; n0 < NCH; n0 += 4) { SC_STEP(R0, R1, n0); SC_STEP(R1, R2, n0 + 1); SC_STEP(R2, R3, n0 + 2); SC_STEP(R3, R0, n0 + 3); }
        __syncthreads();
#undef SC_LOAD
#undef SC_WRITE
#undef SC_UPDATE
#undef SC_STEP
    }
}

__device__ __forceinline__ void phase_gate(const Ctx& F, bf16* Oout) {
    const float* hg = F.in[17]; const f32x4 g4 = *(const f32x4*)(hg + 4 * F.lane);
    bf16* O = F.wsb(WS_O); const bf16* Gt = F.wsb(WS_G);
    const int gw = F.bid * NWAVES + F.wave, NGW = F.G * NWAVES;
    for (int it = gw; it < M * 4; it += NGW) {
        const size_t off = (size_t)it * 256 + 4 * F.lane;
        const u32x2 ov = *(const u32x2*)(O + off), gv = *(const u32x2*)(Gt + off);
        const float o0 = __uint_as_float(ov.x << 16), o1 = __uint_as_float(ov.x & 0xffff0000u), o2 = __uint_as_float(ov.y << 16), o3 = __uint_as_float(ov.y & 0xffff0000u);
        const float x0 = __uint_as_float(gv.x << 16), x1 = __uint_as_float(gv.x & 0xffff0000u), x2 = __uint_as_float(gv.y << 16), x3 = __uint_as_float(gv.y & 0xffff0000u);
        const float rs = rsqrtf(wave_sum((o0 * o0 + o1 * o1) + (o2 * o2 + o3 * o3)) * (1.0f / 256.0f) + EPS);
        u32x2 r; r.x = cvtpk(o0 * rs * g4.x * siluf_(x0), o1 * rs * g4.y * siluf_(x1)); r.y = cvtpk(o2 * rs * g4.z * siluf_(x2), o3 * rs * g4.w * siluf_(x3));
        *(u32x2*)(Oout + off) = r;
    }
}
__device__ __forceinline__ void phase_final(const Ctx& F, float* dst) {
    const float* fg = F.in[19]; const float* ssq = F.wsf(WS_SSQ);
    const int gw = F.bid * NWAVES + F.wave, NGW = F.G * NWAVES;
    for (int m = gw; m < M; m += NGW) {
        float s = F.lane < 16 ? ssq[(size_t)m * 16 + F.lane] : 0.f; s = wave_sum(s);
        const float rs = rsqrtf(s * (1.0f / D) + EPS);
        const u32x2* xr = (const u32x2*)(F.wsb(WS_HB) + (size_t)m * D) + F.lane; f32x4* dr = (f32x4*)(dst + (size_t)m * D) + F.lane;
#pragma unroll
        for (int j = 0; j < 4; ++j) { const f32x4 g = *((const f32x4*)fg + F.lane + 64 * j); const u32x2 hv = xr[64 * j];
            f32x4 v = {__uint_as_float(hv.x << 16), __uint_as_float(hv.x & 0xffff0000u), __uint_as_float(hv.y << 16), __uint_as_float(hv.y & 0xffff0000u)}; v = v * rs * g; dr[64 * j] = v; }
    }
}
__device__ __forceinline__ void phase_r(const Ctx& F) {
    const bf16* Wr = F.wsb(WS_W_IN1) + (size_t)GN * D; const bf16* hb = F.wsb(WS_HB); const float* ssq = F.wsf(WS_SSQ); float* R = F.wsf(WS_R);
    const int gw = F.bid * NWAVES + F.wave, NGW = F.G * NWAVES;
    for (int t = gw; t < M / 16; t += NGW) {
        const int fr = F.lane & 15, fq = F.lane >> 4; const int row = t * 16 + fr;
        const f32x4 p = *(const f32x4*)(ssq + (size_t)row * 16 + 4 * fq); float s = (p.x + p.y) + (p.z + p.w); s += __shfl_xor(s, 16); s += __shfl_xor(s, 32);
        const float rs = rsqrtf(s * (1.0f / D) + EPS);
        const f32x4 acc = skinny_task(hb + (size_t)t * 16 * D, D, Wr, D, D, F.lane) * rs;
        *(f32x4*)(R + (size_t)row * 16 + 4 * fq) = acc;
    }
}
__device__ __forceinline__ void meta_in1(const Ctx& F) {
    const bf16* hbm = F.wsb(WS_META + MT_HBM); const float* ssqm = F.wsf(WS_META + MT_SSQM); const bf16* Wt = F.wsb(WS_W_IN1);
    for (int t = meta_task_id(F); t < (GNR - 512) / 16; t += F.G * NWAVES) {
        const int n0 = 512 + t * 16; if (n0 >= 2048 && n0 < GN) continue;
        const int fr = F.lane & 15, fq = F.lane >> 4;
        const float rs = meta_rs(ssqm, F.lane); const f32x4 acc = skinny_task(hbm, D, Wt + (size_t)n0 * D, D, D, F.lane) * rs;
        u32x2 o; o.x = cvtpk(acc[0], acc[1]); o.y = cvtpk(acc[2], acc[3]);
        if (n0 < 1024) *(u32x2*)(F.wsb(WS_META + MT_KM) + (size_t)fr * 512 + (n0 - 512) + 4 * fq) = o;
        else if (n0 < 2048) *(u32x2*)(F.wsb(WS_META + MT_VM) + (size_t)fr * 1024 + (n0 - 1024) + 4 * fq) = o;
        else *(f32x4*)(F.wsf(WS_META + MT_RM) + fr * 16 + 4 * fq) = acc;
    }
}


constexpr int CW_BAR = 4096;
constexpr int LDSCTL_OFF = LDS_BYTES - 512, MISC_OFF = LDSCTL_OFF + 320;
#define XB_TMO      128
#define XB_XCNT(j)  (256  + 64 * (j))
#define XB_XSUB(j)  (1280 + 64 * (j))
#define XB_XGEN(j)  (2304 + 64 * (j))
#define XB_TOP      3328
#define XB_TOPGEN   3392
#define XCD_BAR_WORDS 3456
#define XB_SPIN_CAP (1u << 18)
__device__ __forceinline__ unsigned xb_ld(unsigned* p)              { return __hip_atomic_load(p, __ATOMIC_RELAXED, __HIP_MEMORY_SCOPE_AGENT); }
__device__ __forceinline__ unsigned xb_add(unsigned* p, unsigned v) { return __hip_atomic_fetch_add(p, v, __ATOMIC_RELAXED, __HIP_MEMORY_SCOPE_AGENT); }
__device__ __forceinline__ unsigned xb_xcc_id() { return (unsigned)__builtin_amdgcn_s_getreg((3 << 11) | 20) & 0xFu; }
#define XB_SPIN(cond, bar) do { unsigned _sp = 0; while (cond) { __builtin_amdgcn_s_sleep(1); \
    if ((++_sp & 255u) == 0u) { if (xb_ld(&(bar)[XB_TMO])) break; if (_sp > XB_SPIN_CAP) { atomicAdd(&(bar)[XB_TMO], 1u); break; } } } } while (0)
struct XcdBarrier { unsigned* bar; unsigned x; volatile LAS unsigned* st; };
__device__ __forceinline__ XcdBarrier xcd_barrier_post(unsigned* bar, volatile LAS unsigned* st) {
    XcdBarrier b; b.bar = bar; b.x = xb_xcc_id(); b.st = st;
    if (threadIdx.x == 0) (void)xb_add(&bar[XB_XCNT(b.x)], 1u);
    return b;
}
__device__ __forceinline__ void xcd_barrier_complete(unsigned* bar, unsigned x, unsigned& nloc, unsigned& nx) {
    const unsigned G = gridDim.x * gridDim.y * gridDim.z;
    unsigned sum, cnt, mine, sp = 0u;
    for (;;) {
        sum = 0u; cnt = 0u; mine = 0u;
#pragma unroll
        for (unsigned j = 0; j < 16; ++j) { const unsigned c = xb_ld(&bar[XB_XCNT(j)]); sum += c; cnt += (c > 0u) ? 1u : 0u; mine = (j == x) ? c : mine; }
        if (sum == G) break;
        __builtin_amdgcn_s_sleep(1);
        if ((++sp & 255u) == 0u) { if (xb_ld(&bar[XB_TMO])) break; if (sp > XB_SPIN_CAP) { atomicAdd(&bar[XB_TMO], 1u); break; } }
    }
    nloc = mine > 0u ? mine : 1u; nx = cnt > 0u ? cnt : 1u;
}
__device__ __forceinline__ void xcd_barrier(const XcdBarrier& b) {
    asm volatile("s_waitcnt vmcnt(0)" ::: "memory");
    __syncthreads();
    if (threadIdx.x == 0) {
        unsigned* bar = b.bar;
        __builtin_amdgcn_s_waitcnt(0);
        unsigned nloc = b.st[0], nx = b.st[1];
        if (nloc == 0u) { xcd_barrier_complete(bar, b.x, nloc, nx); b.st[0] = nloc; b.st[1] = nx; }
        const unsigned old = xb_add(&bar[XB_XSUB(b.x)], 1u);
        const unsigned gen = old / nloc;
        if (old + 1u == (gen + 1u) * nloc) {
            __builtin_amdgcn_fence(__ATOMIC_RELEASE, "agent");
            asm volatile("s_waitcnt vmcnt(0)" ::: "memory");
            const unsigned og = xb_add(&bar[XB_TOP], 1u);
            const unsigned tg = og / nx;
            if (og + 1u == (tg + 1u) * nx) xb_add(&bar[XB_TOPGEN], 1u);
            else XB_SPIN(xb_ld(&bar[XB_TOPGEN]) == tg, bar);
            __builtin_amdgcn_fence(__ATOMIC_ACQUIRE, "agent");
            xb_add(&bar[XB_XGEN(b.x)], 1u);
            asm volatile("s_waitcnt vmcnt(0)" ::: "memory");
        } else {
            XB_SPIN(xb_ld(&bar[XB_XGEN(b.x)]) == gen, bar);
            __builtin_amdgcn_fence(__ATOMIC_ACQUIRE, "agent");
            asm volatile("s_waitcnt vmcnt(0)" ::: "memory");
        }
    }
    __syncthreads();
}

constexpr int N_PHASES = 14;
__global__ void __launch_bounds__(NTHREADS, 2) fwd_kernel(Args args) {
    extern __shared__ __attribute__((aligned(16))) unsigned char lds_raw[];
    Ctx F;
#pragma unroll
    for (int i = 0; i < 20; ++i) F.in[i] = args.in[i];
    F.out = args.out; F.ws = args.ws; F.lds = (LAS unsigned char*)lds_raw;
    F.tid = threadIdx.x; F.lane = F.tid & 63; F.wave = __builtin_amdgcn_readfirstlane(F.tid >> 6); F.G = gridDim.x; F.bid = blockIdx.x;
    const int lo = args.ph_lo, hi = args.ph_hi;
    for (int u = F.tid; u < (LDS_BYTES - LDSCTL_OFF) / 4; u += NTHREADS) ((LAS unsigned*)(F.lds + LDSCTL_OFF))[u] = 0u;
    __syncthreads();
    XcdBarrier bar = xcd_barrier_post((unsigned*)(F.ws + WS_CTL) + CW_BAR + args.probe_reps * XCD_BAR_WORDS, (volatile LAS unsigned*)(F.lds + MISC_OFF) + 8);
#define IN(k) (lo <= (k) && (k) < hi)
#define REP(k) for (int r_ = 0, n_ = (args.probe_phase == (k) ? args.probe_reps : 1); r_ < n_; ++r_)
#define SEAM(k) do { if (IN(k) && IN((k) + 1)) xcd_barrier(bar); } while (0)
    if (IN(0)) phase_prologue(F);
    SEAM(0);
    if (IN(1)) {
        meta_scale_gemm<0>(F, F.wsb(WS_W_IN0), ZN0, D, F.wsb(WS_META + MT_ZM));
        EpiBf16S<0, 0> E{F.wsf(WS_SSQ), F.wsb(WS_Z0), ZN0, nullptr, nullptr, nullptr, nullptr};
        gemm_run(F, F.wsb(WS_HB), F.wsb(WS_W_IN0), M, ZN0, D, E);
    }
    SEAM(1);
    if (IN(2)) phase_convpool(F);
    SEAM(2);
    if (IN(3)) {
        meta_resid_gemm(F, F.wsb(WS_META + MT_MIXM), D, F.wsb(WS_W_OUT0), F.in[1]);
        EpiResid<true> E{F.in[0], F.wsb(WS_HB), F.wsf(WS_SSQ)};
        gemm_run(F, F.wsb(WS_MIX0), F.wsb(WS_W_OUT0), M, D, D, E);
    }
    SEAM(3);
    if (IN(4)) {
        meta_scale_gemm<1>(F, F.wsb(WS_W1_0), FF, D, F.wsb(WS_META + MT_AM));
        EpiBf16S<1, 0> E{F.wsf(WS_SSQ), F.wsb(WS_A), FF, nullptr, nullptr, nullptr, nullptr};
        gemm_run(F, F.wsb(WS_HB), F.wsb(WS_W1_0), M, FF, D, E);
    }
    SEAM(4);
    if (IN(5)) {
        meta_resid_gemm(F, F.wsb(WS_META + MT_AM), FF, F.wsb(WS_W2_0), F.wsf(WS_META + MT_HM));
        EpiResid<false> E{nullptr, F.wsb(WS_HB), F.wsf(WS_SSQ)};
        gemm_run(F, F.wsb(WS_A), F.wsb(WS_W2_0), M, D, FF, E);
    }
    SEAM(5);
    if (IN(6)) {
        meta_in1(F);
        phase_r(F);
        EpiBf16S<0, 1> E{F.wsf(WS_SSQ), nullptr, 0, F.wsb(WS_Q), F.wsb(WS_K), F.wsb(WS_V), F.wsb(WS_G)};
        gemm_run(F, F.wsb(WS_HB), F.wsb(WS_W_IN1), M, GN, D, E);
    }
    SEAM(6);
    if (IN(7)) phase_prep(F);
    SEAM(7);
    if (IN(8)) phase_scan(F);
    SEAM(8);
    if (IN(9)) phase_gate(F, F.wsb(WS_O));
    SEAM(9);
    if (IN(10)) {
        EpiResid<false> E{nullptr, F.wsb(WS_HB), F.wsf(WS_SSQ)};
        gemm_run(F, F.wsb(WS_O), F.wsb(WS_W_OUT1), M, D, D, E);
    }
    SEAM(10);
    if (IN(11)) {
        EpiBf16S<1, 0> E{F.wsf(WS_SSQ), F.wsb(WS_A), FF, nullptr, nullptr, nullptr, nullptr};
        gemm_run(F, F.wsb(WS_HB), F.wsb(WS_W1_1), M, FF, D, E);
    }
    SEAM(11);
    if (IN(12)) {
        EpiResid<false> E{nullptr, F.wsb(WS_HB), F.wsf(WS_SSQ)};
        gemm_run(F, F.wsb(WS_A), F.wsb(WS_W2_1), M, D, FF, E);
    }
    SEAM(12);
    if (IN(13)) phase_final(F, F.out);
#undef IN
#undef SEAM
}

extern "C" void kernel_launch(void* const* d_in, const int* in_sizes, int n_in, void* d_out, int out_size, void* d_ws, size_t ws_size, hipStream_t stream) {
    static int grid = 0;
    if (grid == 0) {
        if (n_in != 20 || in_sizes[0] != M * D || out_size != M * D || ws_size < WS_END) { fprintf(stderr, "kernel_launch: unexpected shapes (n_in %d, in0 %d, out %d, ws %zu)\n", n_in, n_in > 0 ? in_sizes[0] : -1, out_size, ws_size); grid = -1; return; }
        int dev = 0, cus = 0, per_cu = 0;
        (void)hipGetDevice(&dev); (void)hipDeviceGetAttribute(&cus, hipDeviceAttributeMultiprocessorCount, dev);
        (void)hipFuncSetAttribute((const void*)fwd_kernel, hipFuncAttributeMaxDynamicSharedMemorySize, LDS_BYTES);
        (void)hipOccupancyMaxActiveBlocksPerMultiprocessor(&per_cu, (const void*)fwd_kernel, NTHREADS, LDS_BYTES);
        (void)hipGetLastError();
        if (per_cu < 1) per_cu = 1;
        grid = cus * (per_cu < 1 ? per_cu : 1);
    }
    if (grid < 0) return;
    (void)hipMemsetAsync((char*)d_ws + WS_CTL, 0, CTL_ZERO_BYTES, stream);
#ifndef PROBE_PHASE
#define PROBE_PHASE -1
#endif
#ifndef PROBE_REPS
#define PROBE_REPS 2
#endif
    Args a{};
    a.probe_phase = PROBE_PHASE; a.probe_reps = 0;
    for (int i = 0; i < 20; ++i) a.in[i] = (const float*)d_in[i];
    a.out = (float*)d_out; a.ws = (unsigned char*)d_ws;
#if defined(MK_PER_PHASE)
    for (int p = 0; p < N_PHASES; ++p) { a.probe_reps = p; a.ph_lo = p; a.ph_hi = p + 1; hipLaunchKernelGGL(fwd_kernel, dim3(grid), dim3(NTHREADS), LDS_BYTES, stream, a); }
#elif defined(PROBE_REPEAT)
    { const int k = PROBE_REPEAT; const int cuts[4] = {0, k + 1, k, k + 1};
      a.ph_lo = 0; a.ph_hi = k + 1; hipLaunchKernelGGL(fwd_kernel, dim3(grid), dim3(NTHREADS), LDS_BYTES, stream, a);
      if (PROBE_TWICE) { a.probe_reps = 1; a.ph_lo = k; a.ph_hi = k + 1; hipLaunchKernelGGL(fwd_kernel, dim3(grid), dim3(NTHREADS), LDS_BYTES, stream, a); }
      a.probe_reps = 2; a.ph_lo = k + 1; a.ph_hi = N_PHASES; hipLaunchKernelGGL(fwd_kernel, dim3(grid), dim3(NTHREADS), LDS_BYTES, stream, a); (void)cuts; }
#else
    a.ph_lo = 0; a.ph_hi = N_PHASES; hipLaunchKernelGGL(fwd_kernel, dim3(grid), dim3(NTHREADS), LDS_BYTES, stream, a);
#endif
}
```
